# Optimizing an MI355X kernel written in HIP

```python
import jax, jax.numpy as jnp
from jax import lax
import numpy as np

D_MODEL = 1024
BATCH = 1
SEQ = 16384
DEPTH = 2
DEC_BATCH = 16
DEC_SEQ = 2048
PAST_LEN = 128

D_MIX = D_MODEL
D_A = D_MIX // 2
D_B = D_MIX - D_A
CHUNK = 128
A_HEADS = 4
A_HEAD_DIM = D_A // A_HEADS
CONV_WIDTH = 31
CONV_PAD = CONV_WIDTH // 2
C_GROUPS = 4
D_FF = ((8 * D_MODEL // 3 + 255) // 256) * 256
N_EVEN = (DEPTH + 1) // 2
EPS = 1e-6

kernel_name = "hybrid_sgmlp_conv_fnet_encoder"


def rms_norm(x, g):
    xf = x.astype(jnp.float32)
    y = xf * lax.rsqrt(jnp.mean(xf * xf, axis=-1, keepdims=True) + EPS)
    return (y * g.astype(jnp.float32)).astype(x.dtype)


def layer_norm(x, g, b):
    xf = x.astype(jnp.float32)
    mu = jnp.mean(xf, axis=-1, keepdims=True)
    xc = xf - mu
    var = jnp.mean(xc * xc, axis=-1, keepdims=True)
    y = xc * lax.rsqrt(var + EPS) * g.astype(jnp.float32) + b.astype(jnp.float32)
    return y.astype(x.dtype)


def swiglu(x, w_gate, w_up, w_down):
    return (jax.nn.silu(x @ w_gate) * (x @ w_up)) @ w_down


def mixer_ab(h, w_in, sg_ln_g, sg_ln_b, sg_w, sg_b, conv_w, conv_b, conv_ln_g, conv_ln_b, w_out):
    bsz, s, _ = h.shape
    proj = h @ w_in
    z = jax.nn.gelu(proj[..., :2 * D_A])
    u, v = z[..., :D_A], z[..., D_A:]
    v = layer_norm(v, sg_ln_g, sg_ln_b)
    v = v.reshape(bsz, s // CHUNK, CHUNK, A_HEADS, A_HEAD_DIM)
    sv = jnp.einsum('hqp,bnphc->bnqhc', sg_w, v) + sg_b.T[None, None, :, :, None]
    a_out = u * sv.reshape(bsz, s, D_A)
    g_in = proj[..., 2 * D_A:]
    c = g_in[..., :D_B] * jax.nn.sigmoid(g_in[..., D_B:])
    c = lax.conv_general_dilated(
        c, conv_w[:, None, :].astype(c.dtype), window_strides=(1,),
        padding=[(CONV_PAD, CONV_PAD)], dimension_numbers=('NWC', 'WIO', 'NWC'),
        feature_group_count=D_B) + conv_b
    c = jax.nn.silu(layer_norm(c, conv_ln_g, conv_ln_b))
    return jnp.concatenate([a_out, c], axis=-1) @ w_out


def mixer_c(h, w_out):
    bsz, s, d = h.shape
    hf = h.astype(jnp.float32).reshape(bsz, s, C_GROUPS, d // C_GROUPS)
    f = jnp.fft.fftn(hf, axes=(1, 3), norm='ortho').real.astype(h.dtype).reshape(bsz, s, d)
    return f @ w_out


def half_ffn(x, pre_g, w_gate, w_up, w_down, post_g):
    return x + 0.5 * rms_norm(swiglu(rms_norm(x, pre_g), w_gate, w_up, w_down), post_g)


def trunk(x, ffn_pre_g, ffn_w_gate, ffn_w_up, ffn_w_down, ffn_post_g,
          mix_pre_g, mix_w_out, mix_post_g, ab_w_in, sg_ln_g, sg_ln_b, sg_w, sg_b,
          conv_w, conv_b, conv_ln_g, conv_ln_b):
    for i in range(DEPTH):
        x = half_ffn(x, ffn_pre_g[i, 0], ffn_w_gate[i, 0], ffn_w_up[i, 0], ffn_w_down[i, 0], ffn_post_g[i, 0])
        h = rms_norm(x, mix_pre_g[i])
        if i % 2 == 0:
            e = i // 2
            m = mixer_ab(h, ab_w_in[e], sg_ln_g[e], sg_ln_b[e], sg_w[e], sg_b[e],
                         conv_w[e], conv_b[e], conv_ln_g[e], conv_ln_b[e], mix_w_out[i])
        else:
            m = mixer_c(h, mix_w_out[i])
        x = x + rms_norm(m, mix_post_g[i])
        x = half_ffn(x, ffn_pre_g[i, 1], ffn_w_gate[i, 1], ffn_w_up[i, 1], ffn_w_down[i, 1], ffn_post_g[i, 1])
    return x


def setup_inputs(seed: int = 0) -> dict:
    key = jax.random.key(seed)
    ks = jax.random.split(key, 19)
    f32 = jnp.float32

    def nrm(k, shape, scale):
        return jax.random.normal(k, shape, f32) * scale

    def gain(k, shape):
        return 1.0 + 0.02 * jax.random.normal(k, shape, f32)

    return {
        "x_prompt": nrm(ks[0], (BATCH, SEQ, D_MODEL), 1.0),
        "x_sample": nrm(ks[1], (DEC_BATCH, DEC_SEQ, D_MODEL), 1.0),
        "ffn_pre_g": gain(ks[2], (DEPTH, 2, D_MODEL)),
        "ffn_w_gate": nrm(ks[3], (DEPTH, 2, D_MODEL, D_FF), D_MODEL ** -0.5),
        "ffn_w_up": nrm(ks[4], (DEPTH, 2, D_MODEL, D_FF), D_MODEL ** -0.5),
        "ffn_w_down": nrm(ks[5], (DEPTH, 2, D_FF, D_MODEL), D_FF ** -0.5),
        "ffn_post_g": gain(ks[6], (DEPTH, 2, D_MODEL)),
        "mix_pre_g": gain(ks[7], (DEPTH, D_MODEL)),
        "mix_w_out": nrm(ks[8], (DEPTH, D_MIX, D_MODEL), D_MIX ** -0.5),
        "mix_post_g": gain(ks[9], (DEPTH, D_MODEL)),
        "ab_w_in": nrm(ks[10], (N_EVEN, D_MODEL, 2 * D_A + 2 * D_B), D_MODEL ** -0.5),
        "sg_ln_g": gain(ks[11], (N_EVEN, D_A)),
        "sg_ln_b": nrm(ks[12], (N_EVEN, D_A), 0.02),
        "sg_w": nrm(ks[13], (N_EVEN, A_HEADS, CHUNK, CHUNK), CHUNK ** -0.5),
        "sg_b": gain(ks[14], (N_EVEN, A_HEADS, CHUNK)),
        "conv_w": nrm(ks[15], (N_EVEN, CONV_WIDTH, D_B), CONV_WIDTH ** -0.5),
        "conv_b": nrm(ks[16], (N_EVEN, D_B), 0.02),
        "conv_ln_g": gain(ks[17], (N_EVEN, D_B)),
        "conv_ln_b": nrm(ks[18], (N_EVEN, D_B), 0.02),
    }


def reference(x_prompt, x_sample, ffn_pre_g, ffn_w_gate, ffn_w_up, ffn_w_down, ffn_post_g,
              mix_pre_g, mix_w_out, mix_post_g, ab_w_in, sg_ln_g, sg_ln_b, sg_w, sg_b,
              conv_w, conv_b, conv_ln_g, conv_ln_b):
    params = (ffn_pre_g, ffn_w_gate, ffn_w_up, ffn_w_down, ffn_post_g,
              mix_pre_g, mix_w_out, mix_post_g, ab_w_in, sg_ln_g, sg_ln_b, sg_w, sg_b,
              conv_w, conv_b, conv_ln_g, conv_ln_b)
    y_prompt = trunk(x_prompt, *params)
    y_sample = trunk(x_sample, *params)
    return (y_prompt, y_sample)
```

```cpp
#include <hip/hip_runtime.h>
#include <hip/hip_bf16.h>
#include <hip/hip_cooperative_groups.h>
#include <cstdio>
namespace cg = cooperative_groups;

typedef unsigned short u16;
typedef unsigned int u32;
typedef __attribute__((ext_vector_type(8))) short bf16x8;
typedef __attribute__((ext_vector_type(16))) float f32x16;
typedef __attribute__((ext_vector_type(4))) float f32x4;
#define DEVI __device__ __forceinline__

#ifndef REP_BIG
#define REP_BIG 1
#endif
#ifndef REP_SMALL
#define REP_SMALL 1
#endif
#ifndef REP_BAR
#define REP_BAR 1
#endif
constexpr int T = 49152;
constexpr int TP = 16384;
constexpr int D = 1024;
constexpr int FF = 2816;
constexpr float EPS = 1e-6f;

constexpr size_t WS_WGU = 0;
constexpr size_t WS_WD = WS_WGU + (size_t)2 * 5632 * 1024 * 2;
constexpr size_t WS_WIN = WS_WD + (size_t)2 * 1024 * 2816 * 2;
constexpr size_t WS_WOUT = WS_WIN + (size_t)2048 * 1024 * 2;
constexpr size_t WS_SGW = WS_WOUT + (size_t)2 * 1024 * 1024 * 2;
constexpr size_t WS_T1 = WS_SGW + (size_t)4 * 128 * 128 * 2;
constexpr size_t WS_T2 = WS_T1 + (size_t)4 * 512 * 256 * 2;
constexpr size_t WS_T3 = WS_T2 + (size_t)256 * 256 * 2;
constexpr size_t WS_STAT = WS_T3 + (size_t)128 * 256 * 2;
constexpr size_t WS_H = WS_STAT + (size_t)T * 4;
constexpr size_t WS_XB = WS_H + (size_t)T * 1024 * 2;
constexpr size_t WS_BIG = WS_XB + (size_t)T * 1024 * 2;
constexpr size_t WS_BAR = WS_BIG + (size_t)T * 2816 * 2;
constexpr size_t WS_END = WS_BAR + 16384;

struct Params {
  const float *xp, *xs, *ffn_pre_g, *w_gate, *w_up, *w_down, *ffn_post_g, *mix_pre_g, *mix_w_out, *mix_post_g,
      *ab_w_in, *sg_ln_g, *sg_ln_b, *sg_w, *sg_b, *conv_w, *conv_b, *conv_ln_g, *conv_ln_b;
  float* out;
  unsigned char* ws;
};

typedef __bf16 bf2v __attribute__((ext_vector_type(2)));
typedef float f2v __attribute__((ext_vector_type(2)));
DEVI u32 pack2(float lo, float hi) {
  f2v v = {lo, hi};
  bf2v r = __builtin_convertvector(v, bf2v);
  return __builtin_bit_cast(u32, r);
}
DEVI void grid_barrier(cg::grid_group& grid) {
  asm volatile("s_waitcnt vmcnt(0) lgkmcnt(0)" ::: "memory");
  grid.sync();
  __builtin_amdgcn_fence(__ATOMIC_ACQUIRE, "agent");
  asm volatile("s_waitcnt vmcnt(0)" ::: "memory");
}
DEVI u16 f2bf(float f) { return (u16)(pack2(f, 0.f) & 0xffffu); }
DEVI float bf_lo(u32 v) { return __uint_as_float(v << 16); }
DEVI float bf_hi(u32 v) { return __uint_as_float(v & 0xffff0000u); }
DEVI float bf2f(u16 h) { return __uint_as_float(((u32)h) << 16); }
DEVI float shx(float v, int m, int lane) {
  return __int_as_float(__builtin_amdgcn_ds_bpermute(((lane ^ m) & 63) << 2, __float_as_int(v)));
}
DEVI float wave_sum(float v, int lane) {
#pragma unroll
  for (int m = 32; m >= 1; m >>= 1) v += shx(v, m, lane);
  return v;
}
DEVI float sigmoidf_(float x) { return __builtin_amdgcn_rcpf(1.f + __builtin_amdgcn_exp2f(-1.4426950408889634f * x)); }
DEVI float siluf_(float x) { return x * sigmoidf_(x); }
DEVI float geluf_(float x) {
  const float u2 = 1.5957691216057308f * (x + 0.044715f * x * x * x);
  return x * sigmoidf_(u2);
}


#define XB_TMO      128
#define XB_XCNT(j)  (256  + 64 * (j))
#define XB_XSUB(j)  (1280 + 64 * (j))
#define XB_XGEN(j)  (2304 + 64 * (j))
#define XB_TOP      3328
#define XB_TOPGEN   3392
#define XCD_BAR_WORDS 3456
#define XB_SPIN_CAP (1u << 20)
#define LAS3 __attribute__((address_space(3)))
DEVI unsigned xb_ld(unsigned* p) { return __hip_atomic_load(p, __ATOMIC_RELAXED, __HIP_MEMORY_SCOPE_AGENT); }
DEVI unsigned xb_add(unsigned* p, unsigned v) { return __hip_atomic_fetch_add(p, v, __ATOMIC_RELAXED, __HIP_MEMORY_SCOPE_AGENT); }
DEVI unsigned xb_xcc_id() { return (unsigned)__builtin_amdgcn_s_getreg((3 << 11) | 20) & 0xFu; }
#define XB_SPIN(cond, bar) do { unsigned _sp = 0; while (cond) { __builtin_amdgcn_s_sleep(1); \
    if ((++_sp & 255u) == 0u) { if (xb_ld(&(bar)[XB_TMO])) break; if (_sp > XB_SPIN_CAP) { atomicAdd(&(bar)[XB_TMO], 1u); break; } } } } while (0)
struct XcdBarrier { unsigned* bar; unsigned x; volatile LAS3 unsigned* st; };
DEVI XcdBarrier xcd_barrier_post(const int TIDX, unsigned* bar, volatile LAS3 unsigned* st) {
  XcdBarrier b; b.bar = bar; b.x = xb_xcc_id(); b.st = st;
  if (TIDX == 0) (void)xb_add(&bar[XB_XCNT(b.x)], 1u);
  return b;
}
DEVI void xcd_barrier_complete(unsigned* bar, unsigned x, unsigned& nloc, unsigned& nx) {
  const unsigned G = gridDim.x * gridDim.y * gridDim.z;
  unsigned sum, cnt, mine, sp = 0u;
  for (;;) {
    sum = 0u; cnt = 0u; mine = 0u;
#pragma unroll
    for (unsigned j = 0; j < 16; ++j) { const unsigned c = xb_ld(&bar[XB_XCNT(j)]); sum += c; cnt += (c > 0u) ? 1u : 0u; mine = (j == x) ? c : mine; }
    if (sum == G) break;
    __builtin_amdgcn_s_sleep(1);
    if ((++sp & 255u) == 0u) { if (xb_ld(&bar[XB_TMO])) break; if (sp > XB_SPIN_CAP) { atomicAdd(&bar[XB_TMO], 1u); break; } }
  }
  nloc = mine > 0u ? mine : 1u; nx = cnt > 0u ? cnt : 1u;
}
DEVI void xcd_barrier(const int TIDX, const XcdBarrier& b) {
  asm volatile("s_waitcnt vmcnt(0) lgkmcnt(0)" ::: "memory");
  __syncthreads();
  if (TIDX == 0) {
    unsigned* bar = b.bar;
    __builtin_amdgcn_s_waitcnt(0);
    unsigned nloc = b.st[0], nx = b.st[1];
    if (nloc == 0u) { xcd_barrier_complete(bar, b.x, nloc, nx); b.st[0] = nloc; b.st[1] = nx; }
    const unsigned old = xb_add(&bar[XB_XSUB(b.x)], 1u);
    const unsigned gen = old / nloc;
    if (old + 1u == (gen + 1u) * nloc) {
      __builtin_amdgcn_fence(__ATOMIC_RELEASE, "agent");
      asm volatile("s_waitcnt vmcnt(0)" ::: "memory");
      const unsigned og = xb_add(&bar[XB_TOP], 1u);
      const unsigned tg = og / nx;
      if (og + 1u == (tg + 1u) * nx) xb_add(&bar[XB_TOPGEN], 1u);
      else XB_SPIN(xb_ld(&bar[XB_TOPGEN]) == tg, bar);
      __builtin_amdgcn_fence(__ATOMIC_ACQUIRE, "agent");
      xb_add(&bar[XB_XGEN(b.x)], 1u);
      asm volatile("s_waitcnt vmcnt(0)" ::: "memory");
    } else {
      XB_SPIN(xb_ld(&bar[XB_XGEN(b.x)]) == gen, bar);
      __builtin_amdgcn_fence(__ATOMIC_ACQUIRE, "agent");
      asm volatile("s_waitcnt vmcnt(0)" ::: "memory");
    }
  }
  __syncthreads();
}

constexpr int BM = 256, BN = 128, BK = 32;
constexpr int LROW = 40;
constexpr int A_BUF = BM * LROW;
constexpr int STAGE = (BM + BN) * LROW;

DEVI void tile_map(int t, int NT, int& mt, int& nt) {
  int xcd = t & 7, s = t >> 3;
  int per = 8 * NT;
  int mgl = s / per, rem = s - mgl * per;
  nt = rem >> 3;
  mt = ((mgl * 8 + xcd) << 3) + (rem & 7);
}

template <class AOff>
DEVI void gemm_mainloop(const int TIDX, const u16* __restrict__ A, AOff aoff, const u16* __restrict__ B, long ldb, int K, u16* lds,
                        f32x16 (&acc)[4][2]) {
  const int tid = TIDX, lane = tid & 63, wave = tid >> 6;
  const int wm = wave >> 1, wn = wave & 1;
  const int c4 = tid & 3, r0 = tid >> 2;
  const u16* ap[4];
  const u16* bp[2];
#pragma unroll
  for (int i = 0; i < 4; ++i) ap[i] = A + aoff(r0 + 64 * i) + c4 * 8;
#pragma unroll
  for (int i = 0; i < 2; ++i) bp[i] = B + (long)(r0 + 64 * i) * ldb + c4 * 8;
#pragma unroll
  for (int mb = 0; mb < 4; ++mb)
#pragma unroll
    for (int nb = 0; nb < 2; ++nb)
#pragma unroll
      for (int j = 0; j < 16; ++j) acc[mb][nb][j] = 0.f;

  uint4 ra[4], rb[2];
  const int nk = K / BK;
#pragma unroll
  for (int i = 0; i < 4; ++i) ra[i] = *(const uint4*)(ap[i]);
#pragma unroll
  for (int i = 0; i < 2; ++i) rb[i] = *(const uint4*)(bp[i]);
  {
    u16* st = lds;
#pragma unroll
    for (int i = 0; i < 4; ++i) *(uint4*)(st + (r0 + 64 * i) * LROW + c4 * 8) = ra[i];
#pragma unroll
    for (int i = 0; i < 2; ++i) *(uint4*)(st + A_BUF + (r0 + 64 * i) * LROW + c4 * 8) = rb[i];
  }
  __syncthreads();
  for (int kt = 0; kt < nk; ++kt) {
    const bool more = (kt + 1 < nk);
    if (more) {
#pragma unroll
      for (int i = 0; i < 4; ++i) ra[i] = *(const uint4*)(ap[i] + (kt + 1) * BK);
#pragma unroll
      for (int i = 0; i < 2; ++i) rb[i] = *(const uint4*)(bp[i] + (kt + 1) * BK);
    }
    const u16* st = lds + (kt & 1) * STAGE;
    const u16* sa = st + (wm * 128 + (lane & 31)) * LROW + (lane >> 5) * 8;
    const u16* sb = st + A_BUF + (wn * 64 + (lane & 31)) * LROW + (lane >> 5) * 8;
#pragma unroll
    for (int ks = 0; ks < 2; ++ks) {
      bf16x8 af[4], bfr[2];
#pragma unroll
      for (int mb = 0; mb < 4; ++mb) af[mb] = *(const bf16x8*)(sa + mb * 32 * LROW + ks * 16);
#pragma unroll
      for (int nb = 0; nb < 2; ++nb) bfr[nb] = *(const bf16x8*)(sb + nb * 32 * LROW + ks * 16);
#pragma unroll
      for (int mb = 0; mb < 4; ++mb)
#pragma unroll
        for (int nb = 0; nb < 2; ++nb)
          acc[mb][nb] = __builtin_amdgcn_mfma_f32_32x32x16_bf16(af[mb], bfr[nb], acc[mb][nb], 0, 0, 0);
    }
    if (more) {
      u16* sw = lds + ((kt + 1) & 1) * STAGE;
#pragma unroll
      for (int i = 0; i < 4; ++i) *(uint4*)(sw + (r0 + 64 * i) * LROW + c4 * 8) = ra[i];
#pragma unroll
      for (int i = 0; i < 2; ++i) *(uint4*)(sw + A_BUF + (r0 + 64 * i) * LROW + c4 * 8) = rb[i];
    }
    __syncthreads();
  }
}


DEVI void epi_store_rm(const int TIDX, f32x16 (&acc)[4][2], u16* dst, long ld, long row0, int col0, bool GELU) {
  const int lane = TIDX & 63, wave = TIDX >> 6, wm = wave >> 1, wn = wave & 1;
#pragma unroll
  for (int mb = 0; mb < 4; ++mb)
#pragma unroll
    for (int nb = 0; nb < 2; ++nb)
#pragma unroll
      for (int rg = 0; rg < 4; ++rg)
#pragma unroll
        for (int i = 0; i < 4; ++i) {
          long row = row0 + wm * 128 + mb * 32 + rg * 8 + (lane >> 5) * 4 + i;
          int col = col0 + wn * 64 + nb * 32 + (lane & 31);
          float v = acc[mb][nb][rg * 4 + i];
          if (GELU) v = geluf_(v);
          dst[row * ld + col] = f2bf(v);
        }
}


#define LAS __attribute__((address_space(3)))
typedef unsigned u32x4 __attribute__((ext_vector_type(4)));
namespace pg8 {
constexpr int BM = 256, BK = 64, HALF = 128, HTB = HALF * BK * 2, STAGE_BYTES = 8 * HTB, NXCD = 8, WGM = 8;
DEVI int lds_byte(int r, int c) { const int st = (r >> 4) * 2 + (c >> 5), rr = r & 15, cc = c & 31, ob = rr * 64 + cc * 2; return st * 1024 + (ob ^ (((ob >> 9) & 1) << 5)); }
DEVI void stage_rc(int b, int& R, int& C) { const int st = b / 1024, sb = b % 1024, swz = sb ^ (((sb >> 9) & 1) << 5); R = (st >> 1) * 16 + swz / 64; C = (st & 1) * 32 + (swz % 64) / 2; }
DEVI int perm32(int rho) { const int n = rho >> 4, i = rho & 15; return 8 * (i >> 2) + 4 * n + (i & 3); }
struct Unit { int pm, pn; };
struct Gemm { const u16* A; const u16* Bt; int M, N, K; };
struct StaticOrder {
  int nM, nN, nwg, G, c;
  DEVI void init(int M, int N, int G_, int c_) { nM = M / BM; nN = N / BM; nwg = nM * nN; G = G_; c = c_; }
  DEVI bool next(int i, Unit& u) const {
    const long L = (long)i * G + c; if (L >= nwg) return false;
    int wgid = (int)L; { const int q = nwg / NXCD, r = nwg % NXCD, xcd = wgid % NXCD, off = wgid / NXCD; wgid = (xcd < r ? xcd * (q + 1) : r * (q + 1) + (xcd - r) * q) + off; }
    const int nig = WGM * nN, gid = wgid / nig, fm = gid * WGM, gsz = (nM - fm) < WGM ? (nM - fm) : WGM;
    u.pm = fm + ((wgid % nig) % gsz); u.pn = (wgid % nig) / gsz; return true;
  }
};
struct AddrPlain {
  const char *A, *B; unsigned rowA, rowB; size_t hA, hB;
  DEVI AddrPlain(const u16* A_, const u16* B_, int K) : A((const char*)A_), B((const char*)B_), rowA(K * 2), rowB(K * 2), hA((size_t)HALF * K * 2), hB((size_t)HALF * K * 2) {}
  DEVI const char* a(const Unit& u) const { return A + (size_t)u.pm * 2 * hA; }
  DEVI const char* b(const Unit& u) const { return B + (size_t)u.pn * 2 * hB; }
};
template <class Epi, class Addr>
DEVI void gemm_phase_ad(const int TIDX, LAS unsigned char* lds, const Gemm g, const Addr& ad, const Epi& E) {
  const int tid = TIDX, wid = __builtin_amdgcn_readfirstlane(tid >> 6), lane = tid & 63, wr = wid >> 2, wc = wid & 3, fr = lane & 15, fq = lane >> 4;
  const int K = g.K, nt = K / BK;
  StaticOrder S; S.init(g.M, g.N, (int)gridDim.x, (int)blockIdx.x);
  unsigned voffA[2], voffB[2];
#pragma unroll
  for (int i = 0; i < 2; ++i) { int R, C; stage_rc(tid * 16 + i * 8192, R, C); const int Rb = Epi::PERM ? ((R & ~31) + perm32(R & 31)) : R;
    voffA[i] = (unsigned)R * ad.rowA + (unsigned)C * 2u; voffB[i] = (unsigned)Rb * ad.rowB + (unsigned)C * 2u; }
  const size_t kstep = (size_t)(BK * 2);
  const size_t hstepA = ad.hA, hstepB = ad.hB;
  const unsigned ldsw = (unsigned)wid * 1024u;
  const int aoff = lds_byte(wr * 64 + fr, fq * 8), boff = lds_byte(wc * 32 + fr, fq * 8);
#define PG8_SA(b, h) (((b) * 2 + (h)) * HTB)
#define PG8_SB(b, h) ((4 + (b) * 2 + (h)) * HTB)
#define PG8_STAGE(bufoff, gbase, voff) do { _Pragma("unroll") for (int _i = 0; _i < 2; ++_i) \
    __builtin_amdgcn_global_load_lds((const unsigned*)((const char*)(gbase) + (voff)[_i]), (LAS unsigned*)(lds + (bufoff) + ldsw + _i * 8192), 16, 0, 0); } while (0)
#define PG8_LDA(dst, b, h) do { _Pragma("unroll") for (int m = 0; m < 4; ++m) _Pragma("unroll") for (int k = 0; k < 2; ++k) dst[m][k] = *(const LAS bf16x8*)(lds + PG8_SA(b, h) + aoff + m * 2048 + k * 1024); } while (0)
#define PG8_LDB(dst, b, h) do { _Pragma("unroll") for (int n = 0; n < 2; ++n) _Pragma("unroll") for (int k = 0; k < 2; ++k) dst[n][k] = *(const LAS bf16x8*)(lds + PG8_SB(b, h) + boff + n * 2048 + k * 1024); } while (0)
#define PG8_MMA(ai, bj, At, Bt) do { __builtin_amdgcn_s_setprio(1); _Pragma("unroll") for (int m = 0; m < 4; ++m) _Pragma("unroll") for (int n = 0; n < 2; ++n) _Pragma("unroll") for (int k = 0; k < 2; ++k) \
    acc[ai][bj][m][n] = __builtin_amdgcn_mfma_f32_16x16x32_bf16(Bt[n][k], At[m][k], acc[ai][bj][m][n], 0, 0, 0); __builtin_amdgcn_s_setprio(0); } while (0)
#define PG8_WAIT_V(n) asm volatile("s_waitcnt vmcnt(" #n ")" ::: "memory")
#define PG8_WAIT_L(n) asm volatile("s_waitcnt lgkmcnt(" #n ")" ::: "memory")
#define PG8_BAR __builtin_amdgcn_s_barrier()
#define PG8_SCHED __builtin_amdgcn_sched_barrier(0)
  Unit cur, nxt; int ui = 0;
  if (!S.next(0, cur)) return;
  f32x4 acc[2][2][4][2];
#pragma unroll
  for (int a = 0; a < 2; ++a)
#pragma unroll
    for (int b = 0; b < 2; ++b)
#pragma unroll
      for (int m = 0; m < 4; ++m)
#pragma unroll
        for (int n = 0; n < 2; ++n) acc[a][b][m][n] = (f32x4){0.f, 0.f, 0.f, 0.f};
  bf16x8 At[4][2], B0[2][2], B1[2][2];
  const char* cA = ad.a(cur); const char* cB = ad.b(cur);
  PG8_STAGE(PG8_SB(0, 0), cB, voffB); PG8_STAGE(PG8_SA(0, 0), cA, voffA); PG8_STAGE(PG8_SB(0, 1), cB + hstepB, voffB); PG8_STAGE(PG8_SA(0, 1), cA + hstepA, voffA);
  if (wr == 1) PG8_BAR;
  PG8_WAIT_V(4); PG8_BAR;
  PG8_STAGE(PG8_SB(1, 0), cB + kstep, voffB); PG8_STAGE(PG8_SA(1, 0), cA + kstep, voffA); PG8_STAGE(PG8_SB(1, 1), cB + hstepB + kstep, voffB);
  PG8_WAIT_V(6); PG8_BAR;
  for (;;) {
    const bool has_next = S.next(ui + 1, nxt);
    const char* nA = has_next ? ad.a(nxt) : cA; const char* nB = has_next ? ad.b(nxt) : cB;
    const typename Epi::Pre pre = E.prefetch(cur, wr, fr);
    for (int t = 0; t < nt; t += 2) {
      const bool last = (t == nt - 2);
      const char* a1 = cA + (size_t)(t + 1) * kstep;
      const char* a2 = last ? nA : cA + (size_t)(t + 2) * kstep; const char* b2 = last ? nB : cB + (size_t)(t + 2) * kstep;
      const char* a3 = a2 + kstep; const char* b3 = b2 + kstep;
      PG8_LDB(B0, 0, 0); PG8_SCHED; PG8_LDA(At, 0, 0); PG8_STAGE(PG8_SA(1, 1), a1 + hstepA, voffA);
      PG8_WAIT_L(8); PG8_BAR; PG8_WAIT_L(0); PG8_MMA(0, 0, At, B0); PG8_BAR; PG8_SCHED;
      PG8_LDB(B1, 0, 1); PG8_STAGE(PG8_SB(0, 0), b2, voffB);
      PG8_BAR; PG8_WAIT_L(0); PG8_MMA(0, 1, At, B1); PG8_BAR;
      PG8_LDA(At, 0, 1); PG8_STAGE(PG8_SA(0, 0), a2, voffA);
      PG8_BAR; PG8_WAIT_L(0); PG8_MMA(1, 0, At, B0); PG8_BAR; PG8_SCHED;
      PG8_STAGE(PG8_SB(0, 1), b2 + hstepB, voffB);
      PG8_WAIT_V(6); PG8_BAR; PG8_MMA(1, 1, At, B1); PG8_BAR;
      PG8_LDB(B0, 1, 0); PG8_SCHED; PG8_LDA(At, 1, 0); PG8_STAGE(PG8_SA(0, 1), a2 + hstepA, voffA);
      PG8_WAIT_L(8); PG8_BAR; PG8_WAIT_L(0); PG8_MMA(0, 0, At, B0); PG8_BAR; PG8_SCHED;
      PG8_LDB(B1, 1, 1); PG8_STAGE(PG8_SB(1, 0), b3, voffB);
      PG8_BAR; PG8_WAIT_L(0); PG8_MMA(0, 1, At, B1); PG8_BAR;
      PG8_LDA(At, 1, 1); PG8_STAGE(PG8_SA(1, 0), a3, voffA);
      PG8_BAR; PG8_WAIT_L(0); PG8_MMA(1, 0, At, B0); PG8_BAR; PG8_SCHED;
      PG8_STAGE(PG8_SB(1, 1), b3 + hstepB, voffB);
      PG8_WAIT_V(6); PG8_BAR; PG8_MMA(1, 1, At, B1); PG8_BAR;
    }
    E(acc, cur, wr, wc, fr, fq, pre);
    if (!has_next) break;
#pragma unroll
    for (int a = 0; a < 2; ++a)
#pragma unroll
      for (int b = 0; b < 2; ++b)
#pragma unroll
        for (int m = 0; m < 4; ++m)
#pragma unroll
          for (int n = 0; n < 2; ++n) acc[a][b][m][n] = (f32x4){0.f, 0.f, 0.f, 0.f};
    cur = nxt; cA = nA; cB = nB; ++ui;
  }
  PG8_WAIT_V(0);
  if (wr == 0) PG8_BAR;
  PG8_BAR;
#undef PG8_SA
#undef PG8_SB
#undef PG8_STAGE
#undef PG8_LDA
#undef PG8_LDB
#undef PG8_MMA
#undef PG8_WAIT_V
#undef PG8_WAIT_L
#undef PG8_BAR
#undef PG8_SCHED
}
template <class Epi>
DEVI void gemm_phase(const int TIDX, LAS unsigned char* lds, const Gemm g, const Epi& E) {
  AddrPlain ad(g.A, g.Bt, g.K);
  gemm_phase_ad(TIDX, lds, g, ad, E);
}
struct PreNone {};
struct PreRows { float s[2][4]; };
struct EpiSwiglu {
  static constexpr bool PERM = true;
  u16* act; const float* stat;
  typedef PreRows Pre;
  DEVI Pre prefetch(const Unit& u, int wr, int fr) const {
    Pre q;
#pragma unroll
    for (int ai = 0; ai < 2; ++ai)
#pragma unroll
      for (int m = 0; m < 4; ++m) q.s[ai][m] = stat[u.pm * BM + wr * 64 + fr + ai * HALF + m * 16];
    return q;
  }
  DEVI void operator()(const f32x4 (&acc)[2][2][4][2], const Unit& u, int wr, int wc, int fr, int fq, const Pre& pre) const {
    const int row0 = u.pm * BM + wr * 64 + fr, col0 = u.pn * 128 + wc * 32 + 8 * fq;
#pragma unroll
    for (int ai = 0; ai < 2; ++ai)
#pragma unroll
      for (int m = 0; m < 4; ++m) {
        const int row = row0 + ai * HALF + m * 16;
        const float r = rsqrtf(pre.s[ai][m] * (1.f / 1024.f) + EPS);
        const float rn = -1.4426950408889634f * r, rr = r * r;
        f32x4 o0, o1;
#pragma unroll
        for (int j = 0; j < 4; ++j) {
          const float g0 = acc[ai][0][m][0][j], g1 = acc[ai][0][m][1][j];
          o0[j] = (g0 * acc[ai][1][m][0][j]) * (rr * __builtin_amdgcn_rcpf(1.f + __builtin_amdgcn_exp2f(g0 * rn)));
          o1[j] = (g1 * acc[ai][1][m][1][j]) * (rr * __builtin_amdgcn_rcpf(1.f + __builtin_amdgcn_exp2f(g1 * rn)));
        }
        u32x4 w; w.x = pack2(o0[0], o0[1]); w.y = pack2(o0[2], o0[3]); w.z = pack2(o1[0], o1[1]); w.w = pack2(o1[2], o1[3]);
        __builtin_nontemporal_store(w, (u32x4*)(act + (size_t)row * FF + col0));
      }
  }
};
struct EpiStore {
  static constexpr bool PERM = true;
  u16* O; int ldc; int gelu_pn; const float* stat;
  typedef PreRows Pre;
  DEVI Pre prefetch(const Unit& u, int wr, int fr) const {
    Pre q;
#pragma unroll
    for (int ai = 0; ai < 2; ++ai)
#pragma unroll
      for (int m = 0; m < 4; ++m) q.s[ai][m] = stat ? stat[u.pm * BM + wr * 64 + fr + ai * HALF + m * 16] : 0.f;
    return q;
  }
  DEVI void operator()(const f32x4 (&acc)[2][2][4][2], const Unit& u, int wr, int wc, int fr, int fq, const Pre& pre) const {
    const int row0 = u.pm * BM + wr * 64 + fr, col0 = u.pn * BM + wc * 32 + 8 * fq;
    const bool ge = u.pn < gelu_pn;
#pragma unroll
    for (int ai = 0; ai < 2; ++ai)
#pragma unroll
      for (int m = 0; m < 4; ++m) {
        const int row = row0 + ai * HALF + m * 16;
        const float r = stat ? rsqrtf(pre.s[ai][m] * (1.f / 1024.f) + EPS) : 1.f;
        u16* rowp = O + (size_t)row * ldc + col0;
#pragma unroll
        for (int bj = 0; bj < 2; ++bj) {
          f32x4 v0 = acc[ai][bj][m][0] * r, v1 = acc[ai][bj][m][1] * r;
          if (ge) {
#pragma unroll
            for (int j = 0; j < 4; ++j) { v0[j] = geluf_(v0[j]); v1[j] = geluf_(v1[j]); }
          }
          u32x4 w; w.x = pack2(v0[0], v0[1]); w.y = pack2(v0[2], v0[3]); w.z = pack2(v1[0], v1[1]); w.w = pack2(v1[2], v1[3]);
          *(u32x4*)(rowp + bj * HALF) = w;
        }
      }
  }
};
template <bool SAMPLE>
struct AddrF1 {
  const char *A, *H; unsigned rowA, rowB; size_t hA, hB;
  DEVI AddrF1(const u16* T1, const u16* H_) : A((const char*)T1), H((const char*)H_), rowA(512), rowB((SAMPLE ? 16 : 128) * 2048), hA((size_t)128 * 512), hB(2048) {}
  DEVI const char* a(const Unit& u) const { const int g = SAMPLE ? (u.pn >> 7) : (u.pn >> 6); return A + (size_t)g * 512 * 512 + (size_t)u.pm * 256 * 512; }
  DEVI const char* b(const Unit& u) const {
    if (SAMPLE) { const int g = u.pn >> 7, bb = (u.pn >> 3) & 15, pair = u.pn & 7; return H + ((size_t)(TP + bb * 2048 + 2 * pair) * 1024 + g * 256) * 2; }
    const int g = u.pn >> 6, pair = u.pn & 63; return H + ((size_t)(2 * pair) * 1024 + g * 256) * 2;
  }
};
template <bool SAMPLE>
struct EpiF1 {
  static constexpr bool PERM = false;
  u16* Zt;
  typedef PreNone Pre;
  DEVI Pre prefetch(const Unit&, int, int) const { return Pre{}; }
  DEVI void operator()(const f32x4 (&acc)[2][2][4][2], const Unit& u, int wr, int wc, int fr, int fq, const Pre&) const {
    const int s = u.pm;
    const int g = SAMPLE ? (u.pn >> 7) : (u.pn >> 6);
    const int bb = (u.pn >> 3) & 15;
    const int pair = SAMPLE ? (u.pn & 7) : (u.pn & 63);
#pragma unroll
    for (int ai = 0; ai < 2; ++ai)
#pragma unroll
      for (int m = 0; m < 4; ++m) {
        const int cp = g * 256 + 128 * ai + 64 * wr + 16 * m + fr;
#pragma unroll
        for (int bj = 0; bj < 2; ++bj) {
          const int n2 = 2 * pair + bj;
          const long rowz = SAMPLE ? (((long)cp * 16 + bb) * 16 + n2) : ((long)cp * 128 + n2);
          u16* dst = Zt + (rowz * 2 + s) * 128 + 32 * wc + 4 * fq;
#pragma unroll
          for (int n = 0; n < 2; ++n) {
            const f32x4 v = acc[ai][bj][m][n];
            uint2 o; o.x = pack2(v[0], v[1]); o.y = pack2(v[2], v[3]);
            *(uint2*)(dst + 16 * n) = o;
          }
        }
      }
  }
};
template <bool SAMPLE>
struct EpiFA {
  static constexpr bool PERM = false;
  u16* Yt;
  typedef PreNone Pre;
  DEVI Pre prefetch(const Unit&, int, int) const { return Pre{}; }
  DEVI void operator()(const f32x4 (&acc)[2][2][4][2], const Unit& u, int wr, int wc, int fr, int fq, const Pre&) const {
    constexpr float W = SAMPLE ? (6.283185307179586f / 2048.f) : (6.283185307179586f / 16384.f);
#pragma unroll
    for (int m = 0; m < 4; ++m) {
      int k1 = 64 * wr + 16 * m + fr;
      asm volatile("" : "+v"(k1));
#pragma unroll
      for (int n = 0; n < 2; ++n) {
        const int n2 = SAMPLE ? 4 * fq : (32 * wc + 16 * n + 4 * fq);
        float ct[4], st[4];
#pragma unroll
        for (int j = 0; j < 4; ++j) {
          const float ang = (float)((n2 + j) * k1) * W;
          ct[j] = __cosf(ang);
          st[j] = __sinf(ang);
        }
#pragma unroll
        for (int bj = 0; bj < 2; ++bj) {
          unsigned off;
          if (SAMPLE) off = ((unsigned)((8 * bj + 2 * wc + n) * 128 + k1) * 1024u + (unsigned)u.pn) * 32u + (unsigned)n2;
          else off = (unsigned)k1 * 262144u + (unsigned)(2 * u.pn + bj) * 256u + (unsigned)n2;
          const f32x4 re = acc[0][bj][m][n], im = acc[1][bj][m][n];
          uint2 o;
          o.x = pack2(re[0] * ct[0] + im[0] * st[0], re[1] * ct[1] + im[1] * st[1]);
          o.y = pack2(re[2] * ct[2] + im[2] * st[2], re[3] * ct[3] + im[3] * st[3]);
          *(uint2*)(Yt + off) = o;
          o.x = pack2(im[0] * ct[0] - re[0] * st[0], im[1] * ct[1] - re[1] * st[1]);
          o.y = pack2(im[2] * ct[2] - re[2] * st[2], im[3] * ct[3] - re[3] * st[3]);
          *(uint2*)(Yt + off + (SAMPLE ? 16 : 128)) = o;
        }
        __builtin_amdgcn_sched_barrier(0);
      }
    }
  }
};
}

template <bool SAMPLE>
DEVI void phase_f1_pg8(const int TIDX, const Params& p, LAS unsigned char* ldsl) {
  pg8::Gemm g{nullptr, nullptr, 512, SAMPLE ? 131072 : 65536, 256};
  pg8::AddrF1<SAMPLE> ad((const u16*)(p.ws + WS_T1), (const u16*)(p.ws + WS_H));
  pg8::EpiF1<SAMPLE> E{(u16*)(p.ws + WS_BIG) + (SAMPLE ? (size_t)262144 * 256 : 0)};
  pg8::gemm_phase_ad(TIDX, ldsl, g, ad, E);
}
template <bool SAMPLE>
DEVI void phase_fa_pg8(const int TIDX, const Params& p, LAS unsigned char* ldsl) {
  pg8::Gemm g{(const u16*)(p.ws + WS_T2), (const u16*)(p.ws + WS_BIG) + (SAMPLE ? (size_t)262144 * 256 : 0), 256, SAMPLE ? 262144 : 131072, 256};
  pg8::EpiFA<SAMPLE> E{(u16*)(p.ws + WS_BIG) + (SAMPLE ? (size_t)0 : (size_t)131072 * 256)};
  pg8::gemm_phase(TIDX, ldsl, g, E);
}


DEVI void phase_g1(const int TIDX, const Params& p, int f, LAS unsigned char* ldsl) {
  pg8::Gemm g{(const u16*)(p.ws + WS_XB), (const u16*)(p.ws + WS_WGU) + (size_t)(f & 1) * 5632 * 1024, T, 5632, 1024};
  pg8::EpiSwiglu E{(u16*)(p.ws + WS_BIG), (const float*)(p.ws + WS_STAT)};
  pg8::gemm_phase(TIDX, ldsl, g, E);
}
DEVI void phase_g2(const int TIDX, const Params& p, int f, LAS unsigned char* ldsl) {
  pg8::Gemm g{(const u16*)(p.ws + WS_BIG), (const u16*)(p.ws + WS_WD) + (size_t)(f & 1) * 1024 * 2816, T, 1024, FF};
  pg8::EpiStore E{(u16*)(p.ws + WS_H), 1024, 0, nullptr};
  pg8::gemm_phase(TIDX, ldsl, g, E);
}
DEVI void phase_gin(const int TIDX, const Params& p, LAS unsigned char* ldsl) {
  pg8::Gemm g{(const u16*)(p.ws + WS_XB), (const u16*)(p.ws + WS_WIN), T, 2048, 1024};
  pg8::EpiStore E{(u16*)(p.ws + WS_BIG), 2048, 4, (const float*)(p.ws + WS_STAT)};
  pg8::gemm_phase(TIDX, ldsl, g, E);
}
DEVI void phase_gout(const int TIDX, const Params& p, int layer, LAS unsigned char* ldsl) {
  pg8::Gemm g{(const u16*)(p.ws + WS_H), (const u16*)(p.ws + WS_WOUT) + (size_t)layer * 1024 * 1024, T, 1024, 1024};
  pg8::EpiStore E{(u16*)(p.ws + WS_BIG), 1024, 0, nullptr};
  pg8::gemm_phase(TIDX, ldsl, g, E);
}

DEVI void phase_sgu(const int TIDX, const Params& p, u16* lds) {
  const int SB = TIDX >> 8, TID = TIDX & 255;
  lds += SB * 32768;
  const u16* vt = (const u16*)(p.ws + WS_BIG) + (size_t)T * 2048;
  const u16* sgw = (const u16*)(p.ws + WS_SGW);
  const u16* proj = (const u16*)(p.ws + WS_BIG);
  u16* cat = (u16*)(p.ws + WS_H);
  const int ntiles = 768;
  const int lane = TID & 63, wave = TID >> 6, wm = wave >> 1, wn = wave & 1;
  for (int t = 2 * blockIdx.x + SB; t < ntiles; t += 2 * gridDim.x) {
    int mt, nt;
    tile_map(t, 1, mt, nt);
    const int head = mt / 192;
    f32x16 acc[4][2];
    const long arow0 = (long)mt * 256;
    gemm_mainloop(TID, vt, [=](int r) { return (arow0 + r) * 128; }, sgw + head * 128 * 128, 128, 128, lds, acc);
#pragma unroll
    for (int nb = 0; nb < 2; ++nb) {
      const int q = wn * 64 + nb * 32 + (lane & 31);
      const float bias = p.sg_b[head * 128 + q];
#pragma unroll
      for (int mb = 0; mb < 4; ++mb)
#pragma unroll
        for (int rg = 0; rg < 4; ++rg) {
          int rh = (mt % 192) * 256 + wm * 128 + mb * 32 + rg * 8 + (lane >> 5) * 4;
          int chunk = rh >> 7, c = rh & 127;
          long token = (long)chunk * 128 + q;
          uint2 uv = *(const uint2*)(proj + token * 2048 + head * 128 + c);
          float o0 = (acc[mb][nb][rg * 4 + 0] + bias) * bf_lo(uv.x);
          float o1 = (acc[mb][nb][rg * 4 + 1] + bias) * bf_hi(uv.x);
          float o2 = (acc[mb][nb][rg * 4 + 2] + bias) * bf_lo(uv.y);
          float o3 = (acc[mb][nb][rg * 4 + 3] + bias) * bf_hi(uv.y);
          uint2 ov;
          ov.x = pack2(o0, o1);
          ov.y = pack2(o2, o3);
          *(uint2*)(cat + token * 1024 + head * 128 + c) = ov;
        }
    }
  }
}

template <bool SAMPLE>
DEVI void phase_f1(const int TIDX, const Params& p, u16* lds) {
  const int SB = TIDX >> 8, TID = TIDX & 255;
  lds += SB * 32768;
  const u16* H = (const u16*)(p.ws + WS_H);
  const u16* T1 = (const u16*)(p.ws + WS_T1);
  u16* Zt = (u16*)(p.ws + WS_BIG);
  const int NT = 16, MT = SAMPLE ? 128 : 64, ntiles = MT * NT;
  const int lane = TID & 63, wave = TID >> 6, wm = wave >> 1, wn = wave & 1;
  for (int t = 2 * blockIdx.x + SB; t < ntiles; t += 2 * gridDim.x) {
    int mt, nt;
    tile_map(t, NT, mt, nt);
    const int g = nt >> 2, nq = nt & 3;
    f32x16 acc[4][2];
    if (SAMPLE) {
      const long tb = TP + (long)(mt >> 3) * 2048 + 2 * (mt & 7);
      gemm_mainloop(TID, H, [=](int r) { return (tb + (long)(r & 127) * 16 + (r >> 7)) * 1024 + g * 256; },
                    T1 + (size_t)nq * 128 * 256, 256, 256, lds, acc);
    } else {
      const long tb = 2 * mt;
      gemm_mainloop(TID, H, [=](int r) { return (tb + (long)(r & 127) * 128 + (r >> 7)) * 1024 + g * 256; },
                    T1 + (size_t)nq * 128 * 256, 256, 256, lds, acc);
    }
    const int s = nq >> 1;
#pragma unroll
    for (int nb = 0; nb < 2; ++nb) {
      const int cp = g * 256 + (nq & 1) * 128 + wn * 64 + nb * 32 + (lane & 31);
      long rowz;
      if (SAMPLE) rowz = ((long)cp * 16 + (mt >> 3)) * 16 + 2 * (mt & 7) + wm;
      else rowz = (long)cp * 128 + 2 * mt + wm;
      u16* dst = Zt + (rowz * 2 + s) * 128;
#pragma unroll
      for (int mb = 0; mb < 4; ++mb)
#pragma unroll
        for (int rg = 0; rg < 4; ++rg) {
          int n1 = mb * 32 + rg * 8 + (lane >> 5) * 4;
          uint2 ov;
          ov.x = pack2(acc[mb][nb][rg * 4 + 0], acc[mb][nb][rg * 4 + 1]);
          ov.y = pack2(acc[mb][nb][rg * 4 + 2], acc[mb][nb][rg * 4 + 3]);
          *(uint2*)(dst + n1) = ov;
        }
    }
  }
}

template <bool SAMPLE>
DEVI void phase_fa(const int TIDX, const Params& p, u16* lds) {
  const int SB = TIDX >> 8, TID = TIDX & 255;
  lds += SB * 32768;
  const u16* Zt = (const u16*)(p.ws + WS_BIG);
  const u16* T2 = (const u16*)(p.ws + WS_T2);
  u16* Yt = (u16*)(p.ws + WS_BIG) + (SAMPLE ? (size_t)262144 * 256 : (size_t)131072 * 256);
  const int NT = 2, MT = SAMPLE ? 1024 : 512, ntiles = MT * NT;
  const int lane = TID & 63, wave = TID >> 6, wm = wave >> 1, wn = wave & 1;
  for (int t = 2 * blockIdx.x + SB; t < ntiles; t += 2 * gridDim.x) {
    int mt, nt;
    tile_map(t, NT, mt, nt);
    f32x16 acc[4][2];
    const long arow0 = (long)mt * 256;
    gemm_mainloop(TID, Zt, [=](int r) { return (arow0 + r) * 256; }, T2 + (size_t)nt * 128 * 256, 256, 256, lds, acc);
    const int k1 = 32 * (nt * 2 + wn) + (lane & 31);
#pragma unroll
    for (int mb = 0; mb < 4; ++mb)
#pragma unroll
      for (int rg = 0; rg < 4; ++rg) {
        const long row = arow0 + wm * 128 + mb * 32 + rg * 8 + (lane >> 5) * 4;
        float yr[4], yi[4];
        int n2;
        u16 *dre, *dim_;
        if (SAMPLE) {
          n2 = (int)(row & 15);
          int b = (int)((row >> 4) & 15);
          int cp = (int)(row >> 8);
          u16* base = Yt + ((((long)b * 128 + k1) * 1024 + cp) * 2) * 16 + n2;
          dre = base;
          dim_ = base + 16;
        } else {
          n2 = (int)(row & 127);
          int cp = (int)(row >> 7);
          u16* base = Yt + (((long)k1 * 1024 + cp) * 2) * 128 + n2;
          dre = base;
          dim_ = base + 128;
        }
#pragma unroll
        for (int i = 0; i < 4; ++i) {
          float re = acc[mb][0][rg * 4 + i], im = acc[mb][1][rg * 4 + i];
          float ang = (float)((n2 + i) * k1) * (SAMPLE ? (6.283185307179586f / 2048.f) : (6.283185307179586f / 16384.f));
          float ct = __cosf(ang), st = __sinf(ang);
          yr[i] = re * ct + im * st;
          yi[i] = im * ct - re * st;
        }
        uint2 o;
        o.x = pack2(yr[0], yr[1]);
        o.y = pack2(yr[2], yr[3]);
        *(uint2*)dre = o;
        o.x = pack2(yi[0], yi[1]);
        o.y = pack2(yi[2], yi[3]);
        *(uint2*)dim_ = o;
      }
  }
}

DEVI void phase_fb_prompt(const int TIDX, const Params& p, u16* lds) {
  const int SB = TIDX >> 8, TID = TIDX & 255;
  lds += SB * 32768;
  const u16* Yt = (const u16*)(p.ws + WS_BIG) + (size_t)131072 * 256;
  const u16* T3 = (const u16*)(p.ws + WS_T3);
  u16* f = (u16*)(p.ws + WS_H);
  const int ntiles = 512;
  const int lane = TID & 63, wave = TID >> 6, wm = wave >> 1, wn = wave & 1;
  for (int t = 2 * blockIdx.x + SB; t < ntiles; t += 2 * gridDim.x) {
    int mt, nt;
    tile_map(t, 1, mt, nt);
    f32x16 acc[4][2];
    const long arow0 = (long)mt * 256;
    gemm_mainloop(TID, Yt, [=](int r) { return (arow0 + r) * 256; }, T3, 256, 256, lds, acc);
#pragma unroll
    for (int nb = 0; nb < 2; ++nb) {
      const int k2 = wn * 64 + nb * 32 + (lane & 31);
#pragma unroll
      for (int mb = 0; mb < 4; ++mb)
#pragma unroll
        for (int rg = 0; rg < 4; ++rg) {
          long row = arow0 + wm * 128 + mb * 32 + rg * 8 + (lane >> 5) * 4;
          int k1 = (int)(row >> 10), cp = (int)(row & 1023);
          long token = k1 + 128 * k2;
          uint2 o;
          o.x = pack2(acc[mb][nb][rg * 4 + 0], acc[mb][nb][rg * 4 + 1]);
          o.y = pack2(acc[mb][nb][rg * 4 + 2], acc[mb][nb][rg * 4 + 3]);
          *(uint2*)(f + token * 1024 + cp) = o;
        }
    }
  }
}

DEVI void phase_fb_sample(const int TIDX, const Params& p) {
  const u16* Yt = (const u16*)(p.ws + WS_BIG);
  u16* f = (u16*)(p.ws + WS_H);
  const int lane = TIDX & 63, wave = TIDX >> 6;
  const int col = lane & 15, kg = lane >> 4;
  bf16x8 bfrag;
#pragma unroll
  for (int j = 0; j < 8; ++j) {
    int k = kg * 8 + j, s = k >> 4, n2 = k & 15;
    int ph = (col * n2) & 15;
    float v = (s == 0 ? cospif((float)ph * 0.125f) : sinpif((float)ph * 0.125f)) * 0.25f;
    bfrag[j] = (short)f2bf(v);
  }
  const int G = 131072;
  const int nw = gridDim.x * 8;
  for (int g0 = blockIdx.x * 8 + wave; g0 < G; g0 += 4 * nw) {
    bf16x8 afrag[4];
#pragma unroll
    for (int i = 0; i < 4; ++i) {
      const long row0 = (long)(g0 + i * nw) * 16;
      afrag[i] = *(const bf16x8*)(Yt + (row0 + (lane & 15)) * 32 + kg * 8);
    }
#pragma unroll
    for (int i = 0; i < 4; ++i) {
      f32x4 acc = {0.f, 0.f, 0.f, 0.f};
      acc = __builtin_amdgcn_mfma_f32_16x16x32_bf16(afrag[i], bfrag, acc, 0, 0, 0);
      const long row = (long)(g0 + i * nw) * 16 + 4 * kg;
      const int cp = (int)(row & 1023), k1 = (int)((row >> 10) & 127), b = (int)(row >> 17);
      const long token = TP + (long)b * 2048 + k1 + 128 * col;
      uint2 o;
      o.x = pack2(acc[0], acc[1]);
      o.y = pack2(acc[2], acc[3]);
      *(uint2*)(f + token * 1024 + cp) = o;
    }
  }
}

DEVI void phase_norm(const int TIDX, const Params& p, int mode, const u16* y, float scale, const float* post_g) {
  u16* xb = (u16*)(p.ws + WS_XB);
  float* stat = (float*)(p.ws + WS_STAT);
  const int lane = TIDX & 63, wave = TIDX >> 6;
  const int stride = gridDim.x * 8;
  int row = blockIdx.x * 8 + wave;
  if (mode == 0) {
    for (; row < T; row += stride) {
      const float* xsrc = row < TP ? p.xp + (long)row * 1024 : p.xs + (long)(row - TP) * 1024;
      float ss = 0.f;
#pragma unroll
      for (int j = 0; j < 2; ++j) {
        const float4 a = *(const float4*)(xsrc + j * 512 + lane * 8), b = *(const float4*)(xsrc + j * 512 + lane * 8 + 4);
        ss += a.x * a.x + a.y * a.y + a.z * a.z + a.w * a.w + b.x * b.x + b.y * b.y + b.z * b.z + b.w * b.w;
        uint4 o;
        o.x = pack2(a.x, a.y); o.y = pack2(a.z, a.w); o.z = pack2(b.x, b.y); o.w = pack2(b.z, b.w);
        *(uint4*)(xb + (long)row * 1024 + j * 512 + lane * 8) = o;
      }
      ss = wave_sum(ss, lane);
      if (lane == 0) stat[row] = ss;
    }
    return;
  }
  float gp[2][8];
#pragma unroll
  for (int j = 0; j < 2; ++j) {
    const float4 g0 = *(const float4*)(post_g + j * 512 + lane * 8), g1 = *(const float4*)(post_g + j * 512 + lane * 8 + 4);
    gp[j][0] = g0.x * scale; gp[j][1] = g0.y * scale; gp[j][2] = g0.z * scale; gp[j][3] = g0.w * scale;
    gp[j][4] = g1.x * scale; gp[j][5] = g1.y * scale; gp[j][6] = g1.z * scale; gp[j][7] = g1.w * scale;
  }
  uint4 yv[2], xr[2];
  if (row < T) {
#pragma unroll
    for (int j = 0; j < 2; ++j) {
      yv[j] = *(const uint4*)(y + (long)row * 1024 + j * 512 + lane * 8);
      xr[j] = *(const uint4*)(xb + (long)row * 1024 + j * 512 + lane * 8);
    }
  }
  while (row < T) {
    const int nrow = row + stride;
    uint4 yn[2], xn[2];
    if (nrow < T) {
#pragma unroll
      for (int j = 0; j < 2; ++j) {
        yn[j] = *(const uint4*)(y + (long)nrow * 1024 + j * 512 + lane * 8);
        xn[j] = *(const uint4*)(xb + (long)nrow * 1024 + j * 512 + lane * 8);
      }
    } else {
#pragma unroll
      for (int j = 0; j < 2; ++j) { yn[j] = yv[j]; xn[j] = xr[j]; }
    }
    float xv[2][8], yf[2][8];
    float ss = 0.f;
#pragma unroll
    for (int j = 0; j < 2; ++j) {
      yf[j][0] = bf_lo(yv[j].x); yf[j][1] = bf_hi(yv[j].x); yf[j][2] = bf_lo(yv[j].y); yf[j][3] = bf_hi(yv[j].y);
      yf[j][4] = bf_lo(yv[j].z); yf[j][5] = bf_hi(yv[j].z); yf[j][6] = bf_lo(yv[j].w); yf[j][7] = bf_hi(yv[j].w);
      xv[j][0] = bf_lo(xr[j].x); xv[j][1] = bf_hi(xr[j].x); xv[j][2] = bf_lo(xr[j].y); xv[j][3] = bf_hi(xr[j].y);
      xv[j][4] = bf_lo(xr[j].z); xv[j][5] = bf_hi(xr[j].z); xv[j][6] = bf_lo(xr[j].w); xv[j][7] = bf_hi(xr[j].w);
#pragma unroll
      for (int e = 0; e < 8; ++e) ss += yf[j][e] * yf[j][e];
    }
    ss = wave_sum(ss, lane);
    const float r = rsqrtf(ss * (1.f / 1024.f) + EPS);
    float sx = 0.f;
#pragma unroll
    for (int j = 0; j < 2; ++j)
#pragma unroll
      for (int e = 0; e < 8; ++e) {
        xv[j][e] += yf[j][e] * r * gp[j][e];
        sx += xv[j][e] * xv[j][e];
      }
    if (mode == 2) {
#pragma unroll
      for (int j = 0; j < 2; ++j) {
        float4 a, b;
        a.x = xv[j][0]; a.y = xv[j][1]; a.z = xv[j][2]; a.w = xv[j][3]; b.x = xv[j][4]; b.y = xv[j][5]; b.z = xv[j][6]; b.w = xv[j][7];
        *(float4*)(p.out + (long)row * 1024 + j * 512 + lane * 8) = a;
        *(float4*)(p.out + (long)row * 1024 + j * 512 + lane * 8 + 4) = b;
      }
    } else {
#pragma unroll
      for (int j = 0; j < 2; ++j) {
        uint4 o;
        o.x = pack2(xv[j][0], xv[j][1]); o.y = pack2(xv[j][2], xv[j][3]); o.z = pack2(xv[j][4], xv[j][5]); o.w = pack2(xv[j][6], xv[j][7]);
        *(uint4*)(xb + (long)row * 1024 + j * 512 + lane * 8) = o;
      }
      sx = wave_sum(sx, lane);
      if (lane == 0) stat[row] = sx;
      if (mode == 3) {
        const float rx = rsqrtf(sx * (1.f / 1024.f) + EPS);
        u16* hrow = (u16*)(p.ws + WS_H) + (long)row * 1024;
#pragma unroll
        for (int j = 0; j < 2; ++j) {
          uint4 o;
          o.x = pack2(xv[j][0] * rx, xv[j][1] * rx); o.y = pack2(xv[j][2] * rx, xv[j][3] * rx);
          o.z = pack2(xv[j][4] * rx, xv[j][5] * rx); o.w = pack2(xv[j][6] * rx, xv[j][7] * rx);
          *(uint4*)(hrow + j * 512 + lane * 8) = o;
        }
      }
    }
#pragma unroll
    for (int j = 0; j < 2; ++j) { yv[j] = yn[j]; xr[j] = xn[j]; }
    row = nrow;
  }
}

DEVI void tconv_tile(const int TIDX, const float* __restrict__ src, int ldsrc, u16* __restrict__ dst, int lddst, int k0, int n0, int rm,
                     float* tl, const float* __restrict__ kscale) {
  const int tid = TIDX;
  {
    const int nn4 = (tid & 15) * 4, kk = tid >> 4;
#pragma unroll
    for (int i = 0; i < 4; ++i) {
      float4 v = *(const float4*)(src + (long)(k0 + kk + 16 * i) * ldsrc + n0 + nn4);
      const float ks = kscale ? kscale[k0 + kk + 16 * i] : 1.f;
      float* d = tl + (kk + 16 * i) * 65 + nn4;
      d[0] = v.x * ks; d[1] = v.y * ks; d[2] = v.z * ks; d[3] = v.w * ks;
    }
  }
  __syncthreads();
  {
    const int kk8 = (tid & 7) * 8, nn = tid >> 3;
#pragma unroll
    for (int i = 0; i < 2; ++i) {
      int n = nn + 32 * i;
      float v[8];
#pragma unroll
      for (int j = 0; j < 8; ++j) v[j] = tl[(kk8 + j) * 65 + n];
      uint4 o;
      o.x = pack2(v[0], v[1]); o.y = pack2(v[2], v[3]); o.z = pack2(v[4], v[5]); o.w = pack2(v[6], v[7]);
      int ng = n0 + n;
      int drow = (rm == 0) ? ng : (256 * (ng >> 7) + (ng & 127) + (rm == 2 ? 128 : 0));
      *(uint4*)(dst + (long)drow * lddst + k0 + kk8) = o;
    }
  }
  __syncthreads();
}

DEVI void prep_ffn_tile(const int TID, const Params& p, int f, int t, float* tl) {
  const int kind = t / 704, tt = t - kind * 704, j = f & 1;
  if (kind < 2) {
    const float* src = (kind ? p.w_up : p.w_gate) + (size_t)f * 1024 * 2816;
    u16* dst = (u16*)(p.ws + WS_WGU) + (size_t)j * 5632 * 1024;
    tconv_tile(TID, src, 2816, dst, 1024, (tt & 15) * 64, (tt >> 4) * 64, kind ? 2 : 1, tl, p.ffn_pre_g + f * 1024);
  } else {
    const float* src = p.w_down + (size_t)f * 2816 * 1024;
    u16* dst = (u16*)(p.ws + WS_WD) + (size_t)j * 1024 * 2816;
    tconv_tile(TID, src, 1024, dst, 2816, (tt % 44) * 64, (tt / 44) * 64, 0, tl, nullptr);
  }
}
DEVI void prep_ffn_in_tail(const int TIDX, const Params& p, int f, float* tl) {
  if (blockIdx.x < 128 || gridDim.x != 256) return;
  const int SB = TIDX >> 8, TID = TIDX & 255;
  tl += SB * 16384;
  for (int t = 2 * ((int)blockIdx.x - 128) + SB; t < 2112; t += 256) prep_ffn_tile(TID, p, f, t, tl);
}
DEVI void prep_ffn_all(const int TIDX, const Params& p, int f, float* tl) {
  const int SB = TIDX >> 8, TID = TIDX & 255;
  tl += SB * 16384;
  for (int t = 2 * blockIdx.x + SB; t < 2112; t += 2 * gridDim.x) prep_ffn_tile(TID, p, f, t, tl);
}
DEVI void phase_prep(const int TIDX, const Params& p, float* tl) {
  const int SB = TIDX >> 8, TID = TIDX & 255;
  tl += SB * 16384;
  const int ntiles = 2112 + 512 + 512;
  for (int t = 2 * blockIdx.x + SB; t < ntiles; t += 2 * gridDim.x) {
    if (t < 2112) {
      prep_ffn_tile(TID, p, 0, t, tl);
    } else if (t < 2624) {
      int tt = t - 2112;
      tconv_tile(TID, p.ab_w_in, 2048, (u16*)(p.ws + WS_WIN), 1024, (tt & 15) * 64, (tt >> 4) * 64, 0, tl, p.mix_pre_g);
    } else {
      int tt = t - 2624, i = tt >> 8, t2 = tt & 255;
      tconv_tile(TID, p.mix_w_out + (size_t)i * 1024 * 1024, 1024, (u16*)(p.ws + WS_WOUT) + (size_t)i * 1024 * 1024, 1024,
                 (t2 & 15) * 64, (t2 >> 4) * 64, 0, tl, nullptr);
    }
  }
  const int gtid = blockIdx.x * 512 + TIDX, nth = gridDim.x * 512;
  u16* sgw = (u16*)(p.ws + WS_SGW);
  u16* T1 = (u16*)(p.ws + WS_T1);
  u16* T2 = (u16*)(p.ws + WS_T2);
  u16* T3 = (u16*)(p.ws + WS_T3);
  for (int e = gtid; e < 65536 + 524288 + 65536 + 32768; e += nth) {
    if (e < 65536) {
      sgw[e] = f2bf(p.sg_w[e]);
    } else if (e < 65536 + 524288) {
      int i = e - 65536, grp = i >> 17, n = (i >> 8) & 511, k = i & 255;
      int s = n >> 8, m = n & 255;
      int ph = (m * k) & 255;
      float a = (float)ph * (1.f / 128.f);
      float v = (s == 0 ? cospif(a) : -sinpif(a)) * (1.f / 16.f) * p.mix_pre_g[1024 + grp * 256 + k];
      T1[i] = f2bf(v);
    } else if (e < 65536 + 524288 + 65536) {
      int i = e - 65536 - 524288, n = i >> 8, k = i & 255;
      int sp = n >> 7, k1 = n & 127;
      int s = k >> 7, n1 = k & 127;
      int ph = (k1 * n1) & 127;
      float a = (float)ph * (1.f / 64.f);
      float C = cospif(a), S = sinpif(a);
      float v = (sp == 0) ? (s == 0 ? C : S) : (s == 0 ? -S : C);
      T2[i] = f2bf(v * 0.08838834764831845f);
    } else {
      int i = e - 65536 - 524288 - 65536, k2 = i >> 8, k = i & 255;
      int s = k >> 7, n2 = k & 127;
      int ph = (k2 * n2) & 127;
      float a = (float)ph * (1.f / 64.f);
      float v = (s == 0 ? cospif(a) : sinpif(a)) * 0.08838834764831845f;
      T3[i] = f2bf(v);
    }
  }
}

DEVI void phase_lnv(const int TIDX, const Params& p, u16* ldt) {
  const int SB = TIDX >> 8, TID = TIDX & 255;
  ldt += SB * 32768;
  const u16* proj = (const u16*)(p.ws + WS_BIG);
  u16* vt = (u16*)(p.ws + WS_BIG) + (size_t)T * 2048;
  const int lane = TID & 63, wave = TID >> 6, tid = TID;
  constexpr int LR = 132;
  for (int t = 2 * blockIdx.x + SB; t < 1536; t += 2 * gridDim.x) {
    const int chunk = t >> 2, head = t & 3;
    const float g0 = p.sg_ln_g[head * 128 + lane], g1 = p.sg_ln_g[head * 128 + 64 + lane];
    const float b0 = p.sg_ln_b[head * 128 + lane], b1 = p.sg_ln_b[head * 128 + 64 + lane];
#pragma unroll 1
    for (int pb = 0; pb < 4; ++pb) {
      const int pos0 = wave * 32 + pb * 8;
      const u16* src0 = proj + ((long)chunk * 128 + pos0) * 2048 + 512;
      uint4 sv[8];
      u16 h0[8], h1[8];
#pragma unroll
      for (int i = 0; i < 8; ++i) {
        const u16* src = src0 + (long)i * 2048;
        sv[i] = *(const uint4*)(src + lane * 8);
        h0[i] = src[head * 128 + lane];
        h1[i] = src[head * 128 + 64 + lane];
      }
      float sm[8], sq[8];
#pragma unroll
      for (int i = 0; i < 8; ++i) {
        const float e0 = bf_lo(sv[i].x), e1 = bf_hi(sv[i].x), e2 = bf_lo(sv[i].y), e3 = bf_hi(sv[i].y);
        const float e4 = bf_lo(sv[i].z), e5 = bf_hi(sv[i].z), e6 = bf_lo(sv[i].w), e7 = bf_hi(sv[i].w);
        sm[i] = ((e0 + e1) + (e2 + e3)) + ((e4 + e5) + (e6 + e7));
        sq[i] = ((e0 * e0 + e1 * e1) + (e2 * e2 + e3 * e3)) + ((e4 * e4 + e5 * e5) + (e6 * e6 + e7 * e7));
      }
#pragma unroll
      for (int m = 32; m >= 1; m >>= 1) {
#pragma unroll
        for (int i = 0; i < 8; ++i) {
          sm[i] += shx(sm[i], m, lane);
          sq[i] += shx(sq[i], m, lane);
        }
      }
#pragma unroll
      for (int i = 0; i < 8; ++i) {
        const float mean = sm[i] * (1.f / 512.f);
        const float var = fmaxf(sq[i] * (1.f / 512.f) - mean * mean, 0.f);
        const float r = rsqrtf(var + EPS);
        ldt[lane * LR + pos0 + i] = f2bf((bf2f(h0[i]) - mean) * r * g0 + b0);
        ldt[(lane + 64) * LR + pos0 + i] = f2bf((bf2f(h1[i]) - mean) * r * g1 + b1);
      }
    }
    __syncthreads();
#pragma unroll
    for (int it = 0; it < 8; ++it) {
      int item = it * 256 + tid, pg = item & 15, c = item >> 4;
      const uint2* s2 = (const uint2*)(ldt + c * LR + pg * 8);
      uint2 lo = s2[0], hi = s2[1];
      uint4 o;
      o.x = lo.x; o.y = lo.y; o.z = hi.x; o.w = hi.y;
      *(uint4*)(vt + (((long)head * 384 + chunk) * 128 + c) * 128 + pg * 8) = o;
    }
    __syncthreads();
  }
}

template <int RR>
struct ConvRow {
  static DEVI void run(const u32* lc, int tid, const float (&w)[31][2], float (&o)[32][2]) {
    const u32 cv = lc[RR * 256 + tid];
    const float c0 = bf_lo(cv), c1 = bf_hi(cv);
#pragma unroll
    for (int j = 0; j < 31; ++j) {
      const int tt = RR - j;
      if (tt >= 0 && tt < 32) {
        o[tt][0] += w[j][0] * c0;
        o[tt][1] += w[j][1] * c1;
      }
    }
    ConvRow<RR + 1>::run(lc, tid, w, o);
  }
};
template <>
struct ConvRow<62> {
  static DEVI void run(const u32*, int, const float (&)[31][2], float (&)[32][2]) {}
};

DEVI void phase_conv(const int TIDX, const Params& p, unsigned char* ldsb) {
  const int SB = TIDX >> 8, TID = TIDX & 255;
  ldsb += SB * 65536;
  const u16* proj = (const u16*)(p.ws + WS_BIG);
  u16* cat = (u16*)(p.ws + WS_H);
  u32* lc = (u32*)ldsb;
  float* lf = (float*)ldsb;
  const int lane = TID & 63, wave = TID >> 6, tid = TID;
  float w[31][2];
#pragma unroll
  for (int j = 0; j < 31; ++j) {
    float2 wv = *(const float2*)(p.conv_w + j * 512 + 2 * tid);
    w[j][0] = wv.x;
    w[j][1] = wv.y;
  }
  const float2 cb = *(const float2*)(p.conv_b + 2 * tid);
  float lg[8], lb[8];
#pragma unroll
  for (int j = 0; j < 8; ++j) {
    lg[j] = p.conv_ln_g[lane * 8 + j];
    lb[j] = p.conv_ln_b[lane * 8 + j];
  }
  for (int t = 2 * blockIdx.x + SB; t < 1536; t += 2 * gridDim.x) {
    const int t0 = t * 32;
    int seq_lo, seq_hi;
    if (t0 < TP) { seq_lo = 0; seq_hi = TP; }
    else { seq_lo = TP + ((t0 - TP) >> 11) * 2048; seq_hi = seq_lo + 2048; }
#pragma unroll 1
    for (int r0 = 0; r0 < 64; r0 += 32) {
      u32 av[32], gv[32];
#pragma unroll
      for (int i = 0; i < 32; ++i) {
        const int tok = t0 - 15 + r0 + i;
        av[i] = 0; gv[i] = 0;
        if (r0 + i < 62 && tok >= seq_lo && tok < seq_hi) {
          av[i] = *(const u32*)(proj + (long)tok * 2048 + 1024 + 2 * tid);
          gv[i] = *(const u32*)(proj + (long)tok * 2048 + 1536 + 2 * tid);
        }
      }
#pragma unroll
      for (int i = 0; i < 32; ++i) {
        if (r0 + i < 62)
          lc[(r0 + i) * 256 + tid] = pack2(bf_lo(av[i]) * sigmoidf_(bf_lo(gv[i])), bf_hi(av[i]) * sigmoidf_(bf_hi(gv[i])));
      }
    }
    float o[32][2];
#pragma unroll
    for (int i = 0; i < 32; ++i) { o[i][0] = cb.x; o[i][1] = cb.y; }
    ConvRow<0>::run(lc, tid, w, o);
    __syncthreads();
#pragma unroll
    for (int i = 0; i < 32; ++i) {
      float2 ov; ov.x = o[i][0]; ov.y = o[i][1];
      *(float2*)(lf + i * 512 + 2 * tid) = ov;
    }
    __syncthreads();
#pragma unroll 1
    for (int ib = 0; ib < 2; ++ib) {
      float v[4][8], sm[4], sq[4];
#pragma unroll
      for (int i = 0; i < 4; ++i) {
        const int tl = wave * 8 + ib * 4 + i;
        const float4 v0 = *(const float4*)(lf + tl * 512 + lane * 8);
        const float4 v1 = *(const float4*)(lf + tl * 512 + lane * 8 + 4);
        v[i][0] = v0.x; v[i][1] = v0.y; v[i][2] = v0.z; v[i][3] = v0.w; v[i][4] = v1.x; v[i][5] = v1.y; v[i][6] = v1.z; v[i][7] = v1.w;
        sm[i] = ((v0.x + v0.y) + (v0.z + v0.w)) + ((v1.x + v1.y) + (v1.z + v1.w));
      }
#pragma unroll
      for (int m = 32; m >= 1; m >>= 1)
#pragma unroll
        for (int i = 0; i < 4; ++i) sm[i] += shx(sm[i], m, lane);
#pragma unroll
      for (int i = 0; i < 4; ++i) {
        const float mean = sm[i] * (1.f / 512.f);
        sq[i] = 0.f;
#pragma unroll
        for (int j = 0; j < 8; ++j) { v[i][j] -= mean; sq[i] += v[i][j] * v[i][j]; }
      }
#pragma unroll
      for (int m = 32; m >= 1; m >>= 1)
#pragma unroll
        for (int i = 0; i < 4; ++i) sq[i] += shx(sq[i], m, lane);
#pragma unroll
      for (int i = 0; i < 4; ++i) {
        const int tl = wave * 8 + ib * 4 + i;
        const float r = rsqrtf(sq[i] * (1.f / 512.f) + EPS);
#pragma unroll
        for (int j = 0; j < 8; ++j) v[i][j] = siluf_(v[i][j] * r * lg[j] + lb[j]);
        uint4 ov;
        ov.x = pack2(v[i][0], v[i][1]); ov.y = pack2(v[i][2], v[i][3]); ov.z = pack2(v[i][4], v[i][5]); ov.w = pack2(v[i][6], v[i][7]);
        *(uint4*)(cat + (long)(t0 + tl) * 1024 + 512 + lane * 8) = ov;
      }
    }
    __syncthreads();
  }
}

__global__ void __launch_bounds__(512, 2) fwd_megakernel(Params p) {
  cg::grid_group grid = cg::this_grid();
  extern __shared__ __attribute__((aligned(16))) unsigned char lds_raw[];
  u16* lds = (u16*)lds_raw;
  LAS unsigned char* ldsl = (LAS unsigned char*)lds_raw;
  __shared__ uint4 xb_words;
  if (threadIdx.x == 0) xb_words = make_uint4(0u, 0u, 0u, 0u);
  __syncthreads();
  XcdBarrier xb = xcd_barrier_post((int)threadIdx.x, (unsigned*)(p.ws + WS_BAR), (volatile LAS3 unsigned*)&xb_words);
#ifndef PROBE_DUP
#define PROBE_DUP 0
#endif
#if PROBE_DUP
  static constexpr unsigned char prog[] = {0, 1, 1, 2, 2, 3, 4, 4, 5, 6, 7, 7, 19, 17, 17, 18, 18, 35, 33, 33, 34, 34, 51, 8, 9, 10, 11, 12, 13, 23, 23, 67, 49, 49, 50, 50, 83};
#else
  static constexpr unsigned char prog[] = {0, 1, 2, 3, 4, 5, 6, 7, 19, 17, 18, 35, 33, 34, 51, 8, 9, 10, 12, 13, 23, 67, 49, 50, 83};
#endif
  constexpr int NPH = (int)sizeof(prog);
#pragma unroll 1
  for (int ph = 0; ph < NPH; ++ph) {
    const int op = prog[ph] & 15, arg = prog[ph] >> 4;
    const int reps = (op == 1 || op == 2 || op == 4 || op == 7) ? REP_BIG : ((op == 5 || op == 6 || op >= 8) ? REP_SMALL : 1);
    for (int rep = 0; rep < reps; ++rep) {
      if (rep) { int t2 = threadIdx.x; asm volatile("" : "+v"(t2)); xcd_barrier(t2, xb); }
      int tid = threadIdx.x;
      asm volatile("" : "+v"(tid));
    switch (op) {
        case 0:
          phase_prep(tid, p, (float*)lds_raw);
          phase_norm(tid, p, 0, nullptr, 0.f, nullptr);
          break;
        case 1:
          phase_g1(tid, p, arg, ldsl);
          if (arg < 3) {
            if (gridDim.x == 256) prep_ffn_in_tail(tid, p, arg + 1, (float*)lds_raw);
            else prep_ffn_all(tid, p, arg + 1, (float*)lds_raw);
          }
          break;
        case 2: phase_g2(tid, p, arg, ldsl); break;
        case 3: {
          const bool mix = (arg == 1 || arg == 4);
          const int fidx = (arg == 0) ? 0 : (arg == 2) ? 1 : (arg == 3) ? 2 : 3;
          const float* post = mix ? p.mix_post_g + (arg == 1 ? 0 : 1024) : p.ffn_post_g + fidx * 1024;
          phase_norm(tid, p, arg == 5 ? 2 : (arg == 3 ? 3 : 1), (const u16*)(p.ws + (mix ? WS_BIG : WS_H)), mix ? 1.0f : 0.5f, post);
        } break;
        case 4: phase_gin(tid, p, ldsl); break;
        case 5:
          phase_lnv(tid, p, lds);
          phase_conv(tid, p, lds_raw);
          break;
        case 6: phase_sgu(tid, p, lds); break;
        case 7: phase_gout(tid, p, arg, ldsl); break;
        case 8: phase_f1_pg8<false>(tid, p, ldsl); break;
        case 9: phase_fa_pg8<false>(tid, p, ldsl); break;
        case 10: phase_fb_prompt(tid, p, lds); phase_f1_pg8<true>(tid, p, ldsl); break;
        case 12: phase_fa_pg8<true>(tid, p, ldsl); break;
        default: phase_fb_sample(tid, p); break;
      }
    }
    if (ph != NPH - 1) for (int rb = 0; rb < REP_BAR; ++rb) {
      if (p.ws == nullptr) grid_barrier(grid);
      { int t2 = threadIdx.x; asm volatile("" : "+v"(t2)); xcd_barrier(t2, xb); }
    }
  }
}

extern "C" void kernel_launch(void* const* d_in, const int* in_sizes, int n_in, void* d_out, int out_size, void* d_ws,
                              size_t ws_size, hipStream_t stream) {
  static int grid_blocks = 0;
  if (!grid_blocks) {
    int dev = 0, cus = 0, per_cu = 0;
    (void)hipGetDevice(&dev);
    (void)hipDeviceGetAttribute(&cus, hipDeviceAttributeMultiprocessorCount, dev);
    (void)hipFuncSetAttribute((const void*)fwd_megakernel, hipFuncAttributeMaxDynamicSharedMemorySize, 131072);
    (void)hipOccupancyMaxActiveBlocksPerMultiprocessor(&per_cu, fwd_megakernel, 512, 131072);
    if (per_cu > 1) per_cu = 1;
    if (per_cu < 1) per_cu = 1;
    grid_blocks = cus * per_cu;
    if (ws_size < WS_END) {
      fprintf(stderr, "workspace too small: %zu < %zu\n", ws_size, (size_t)WS_END);
      grid_blocks = -1;
    }
  }
  if (grid_blocks < 0) return;
  Params p{};
  p.xp = (const float*)d_in[0]; p.xs = (const float*)d_in[1]; p.ffn_pre_g = (const float*)d_in[2];
  p.w_gate = (const float*)d_in[3]; p.w_up = (const float*)d_in[4]; p.w_down = (const float*)d_in[5];
  p.ffn_post_g = (const float*)d_in[6]; p.mix_pre_g = (const float*)d_in[7]; p.mix_w_out = (const float*)d_in[8];
  p.mix_post_g = (const float*)d_in[9]; p.ab_w_in = (const float*)d_in[10]; p.sg_ln_g = (const float*)d_in[11];
  p.sg_ln_b = (const float*)d_in[12]; p.sg_w = (const float*)d_in[13]; p.sg_b = (const float*)d_in[14];
  p.conv_w = (const float*)d_in[15]; p.conv_b = (const float*)d_in[16]; p.conv_ln_g = (const float*)d_in[17];
  p.conv_ln_b = (const float*)d_in[18];
  p.out = (float*)d_out;
  p.ws = (unsigned char*)d_ws;
  (void)hipMemsetAsync((unsigned char*)d_ws + WS_BAR, 0, 16384, stream);
  void* args[] = {&p};
  hipError_t e = hipLaunchCooperativeKernel((void*)fwd_megakernel, dim3(grid_blocks), dim3(512), args, 131072, stream);
  if (e != hipSuccess) fprintf(stderr, "cooperative launch failed: %s (grid %d)\n", hipGetErrorString(e), grid_blocks);
}
```

```cpp
#include <hip/hip_runtime.h>
#include <hip/hip_bf16.h>
#include <hip/hip_cooperative_groups.h>
#include <cstdio>
namespace cg = cooperative_groups;

typedef unsigned short u16;
typedef unsigned int u32;
typedef __attribute__((ext_vector_type(8))) short bf16x8;
typedef __attribute__((ext_vector_type(16))) float f32x16;
typedef __attribute__((ext_vector_type(4))) float f32x4;
#define DEVI __device__ __forceinline__

#ifndef REP_BIG
#define REP_BIG 1
#endif
#ifndef REP_SMALL
#define REP_SMALL 1
#endif
#ifndef REP_BAR
#define REP_BAR 1
#endif
constexpr int T = 49152;
constexpr int TP = 16384;
constexpr int D = 1024;
constexpr int FF = 2816;
constexpr float EPS = 1e-6f;

constexpr size_t WS_WGU = 0;
constexpr size_t WS_WD = WS_WGU + (size_t)2 * 5632 * 1024 * 2;
constexpr size_t WS_WIN = WS_WD + (size_t)2 * 1024 * 2816 * 2;
constexpr size_t WS_WOUT = WS_WIN + (size_t)2048 * 1024 * 2;
constexpr size_t WS_SGW = WS_WOUT + (size_t)2 * 1024 * 1024 * 2;
constexpr size_t WS_T1 = WS_SGW + (size_t)4 * 128 * 128 * 2;
constexpr size_t WS_T2 = WS_T1 + (size_t)4 * 512 * 256 * 2;
constexpr size_t WS_T3 = WS_T2 + (size_t)256 * 256 * 2;
constexpr size_t WS_STAT = WS_T3 + (size_t)128 * 256 * 2;
constexpr size_t WS_H = WS_STAT + (size_t)T * 4;
constexpr size_t WS_XB = WS_H + (size_t)T * 1024 * 2;
constexpr size_t WS_BIG = WS_XB + (size_t)T * 1024 * 2;
constexpr size_t WS_BAR = WS_BIG + (size_t)T * 2816 * 2;
constexpr size_t WS_END = WS_BAR + 16384;

struct Params {
  const float *xp, *xs, *ffn_pre_g, *w_gate, *w_up, *w_down, *ffn_post_g, *mix_pre_g, *mix_w_out, *mix_post_g,
      *ab_w_in, *sg_ln_g, *sg_ln_b, *sg_w, *sg_b, *conv_w, *conv_b, *conv_ln_g, *conv_ln_b;
  float* out;
  unsigned char* ws;
};

typedef __bf16 bf2v __attribute__((ext_vector_type(2)));
typedef float f2v __attribute__((ext_vector_type(2)));
DEVI u32 pack2(float lo, float hi) {
  f2v v = {lo, hi};
  bf2v r = __builtin_convertvector(v, bf2v);
  return __builtin_bit_cast(u32, r);
}
DEVI void grid_barrier(cg::grid_group& grid) {
  asm volatile("s_waitcnt vmcnt(0) lgkmcnt(0)" ::: "memory");
  grid.sync();
  __builtin_amdgcn_fence(__ATOMIC_ACQUIRE, "agent");
  asm volatile("s_waitcnt vmcnt(0)" ::: "memory");
}
DEVI u16 f2bf(float f) { return (u16)(pack2(f, 0.f) & 0xffffu); }
DEVI float bf_lo(u32 v) { return __uint_as_float(v << 16); }
DEVI float bf_hi(u32 v) { return __uint_as_float(v & 0xffff0000u); }
DEVI float bf2f(u16 h) { return __uint_as_float(((u32)h) << 16); }
DEVI float shx(float v, int m, int lane) {
  return __int_as_float(__builtin_amdgcn_ds_bpermute(((lane ^ m) & 63) << 2, __float_as_int(v)));
}
DEVI float wave_sum(float v, int lane) {
#pragma unroll
  for (int m = 32; m >= 1; m >>= 1) v += shx(v, m, lane);
  return v;
}
DEVI float sigmoidf_(float x) { return __builtin_amdgcn_rcpf(1.f + __builtin_amdgcn_exp2f(-1.4426950408889634f * x)); }
DEVI float siluf_(float x) { return x * sigmoidf_(x); }
DEVI float geluf_(float x) {
  const float u2 = 1.5957691216057308f * (x + 0.044715f * x * x * x);
  return x * sigmoidf_(u2);
}


#define XB_TMO      128
#define XB_XCNT(j)  (256  + 64 * (j))
#define XB_XSUB(j)  (1280 + 64 * (j))
#define XB_XGEN(j)  (2304 + 64 * (j))
#define XB_TOP      3328
#define XB_TOPGEN   3392
#define XCD_BAR_WORDS 3456
#define XB_SPIN_CAP (1u << 20)
#define LAS3 __attribute__((address_space(3)))
DEVI unsigned xb_ld(unsigned* p) { return __hip_atomic_load(p, __ATOMIC_RELAXED, __HIP_MEMORY_SCOPE_AGENT); }
DEVI unsigned xb_add(unsigned* p, unsigned v) { return __hip_atomic_fetch_add(p, v, __ATOMIC_RELAXED, __HIP_MEMORY_SCOPE_AGENT); }
DEVI unsigned xb_xcc_id() { return (unsigned)__builtin_amdgcn_s_getreg((3 << 11) | 20) & 0xFu; }
#define XB_SPIN(cond, bar) do { unsigned _sp = 0; while (cond) { __builtin_amdgcn_s_sleep(1); \
    if ((++_sp & 255u) == 0u) { if (xb_ld(&(bar)[XB_TMO])) break; if (_sp > XB_SPIN_CAP) { atomicAdd(&(bar)[XB_TMO], 1u); break; } } } } while (0)
struct XcdBarrier { unsigned* bar; unsigned x; volatile LAS3 unsigned* st; };
DEVI XcdBarrier xcd_barrier_post(const int TIDX, unsigned* bar, volatile LAS3 unsigned* st) {
  XcdBarrier b; b.bar = bar; b.x = xb_xcc_id(); b.st = st;
  if (TIDX == 0) (void)xb_add(&bar[XB_XCNT(b.x)], 1u);
  return b;
}
DEVI void xcd_barrier_complete(unsigned* bar, unsigned x, unsigned& nloc, unsigned& nx) {
  const unsigned G = gridDim.x * gridDim.y * gridDim.z;
  unsigned sum, cnt, mine, sp = 0u;
  for (;;) {
    sum = 0u; cnt = 0u; mine = 0u;
#pragma unroll
    for (unsigned j = 0; j < 16; ++j) { const unsigned c = xb_ld(&bar[XB_XCNT(j)]); sum += c; cnt += (c > 0u) ? 1u : 0u; mine = (j == x) ? c : mine; }
    if (sum == G) break;
    __builtin_amdgcn_s_sleep(1);
    if ((++sp & 255u) == 0u) { if (xb_ld(&bar[XB_TMO])) break; if (sp > XB_SPIN_CAP) { atomicAdd(&bar[XB_TMO], 1u); break; } }
  }
  nloc = mine > 0u ? mine : 1u; nx = cnt > 0u ? cnt : 1u;
}
DEVI void xcd_barrier(const int TIDX, const XcdBarrier& b) {
  asm volatile("s_waitcnt vmcnt(0) lgkmcnt(0)" ::: "memory");
  __syncthreads();
  if (TIDX == 0) {
    unsigned* bar = b.bar;
    __builtin_amdgcn_s_waitcnt(0);
    unsigned nloc = b.st[0], nx = b.st[1];
    if (nloc == 0u) { xcd_barrier_complete(bar, b.x, nloc, nx); b.st[0] = nloc; b.st[1] = nx; }
    const unsigned old = xb_add(&bar[XB_XSUB(b.x)], 1u);
    const unsigned gen = old / nloc;
    if (old + 1u == (gen + 1u) * nloc) {
      __builtin_amdgcn_fence(__ATOMIC_RELEASE, "agent");
      asm volatile("s_waitcnt vmcnt(0)" ::: "memory");
      const unsigned og = xb_add(&bar[XB_TOP], 1u);
      const unsigned tg = og / nx;
      if (og + 1u == (tg + 1u) * nx) xb_add(&bar[XB_TOPGEN], 1u);
      else XB_SPIN(xb_ld(&bar[XB_TOPGEN]) == tg, bar);
      __builtin_amdgcn_fence(__ATOMIC_ACQUIRE, "agent");
      xb_add(&bar[XB_XGEN(b.x)], 1u);
      asm volatile("s_waitcnt vmcnt(0)" ::: "memory");
    } else {
      XB_SPIN(xb_ld(&bar[XB_XGEN(b.x)]) == gen, bar);
      __builtin_amdgcn_fence(__ATOMIC_ACQUIRE, "agent");
      asm volatile("s_waitcnt vmcnt(0)" ::: "memory");
    }
  }
  __syncthreads();
}

constexpr int BM = 256, BN = 128, BK = 32;
constexpr int LROW = 40;
constexpr int A_BUF = BM * LROW;
constexpr int STAGE = (BM + BN) * LROW;

DEVI void tile_map(int t, int NT, int& mt, int& nt) {
  int xcd = t & 7, s = t >> 3;
  int per = 8 * NT;
  int mgl = s / per, rem = s - mgl * per;
  nt = rem >> 3;
  mt = ((mgl * 8 + xcd) << 3) + (rem & 7);
}

template <class AOff>
DEVI void gemm_mainloop(const int TIDX, const u16* __restrict__ A, AOff aoff, const u16* __restrict__ B, long ldb, int K, u16* lds,
                        f32x16 (&acc)[4][2]) {
  const int tid = TIDX, lane = tid & 63, wave = tid >> 6;
  const int wm = wave >> 1, wn = wave & 1;
  const int c4 = tid & 3, r0 = tid >> 2;
  const u16* ap[4];
  const u16* bp[2];
#pragma unroll
  for (int i = 0; i < 4; ++i) ap[i] = A + aoff(r0 + 64 * i) + c4 * 8;
#pragma unroll
  for (int i = 0; i < 2; ++i) bp[i] = B + (long)(r0 + 64 * i) * ldb + c4 * 8;
#pragma unroll
  for (int mb = 0; mb < 4; ++mb)
#pragma unroll
    for (int nb = 0; nb < 2; ++nb)
#pragma unroll
      for (int j = 0; j < 16; ++j) acc[mb][nb][j] = 0.f;

  uint4 ra[4], rb[2];
  const int nk = K / BK;
#pragma unroll
  for (int i = 0; i < 4; ++i) ra[i] = *(const uint4*)(ap[i]);
#pragma unroll
  for (int i = 0; i < 2; ++i) rb[i] = *(const uint4*)(bp[i]);
  {
    u16* st = lds;
#pragma unroll
    for (int i = 0; i < 4; ++i) *(uint4*)(st + (r0 + 64 * i) * LROW + c4 * 8) = ra[i];
#pragma unroll
    for (int i = 0; i < 2; ++i) *(uint4*)(st + A_BUF + (r0 + 64 * i) * LROW + c4 * 8) = rb[i];
  }
  __syncthreads();
  for (int kt = 0; kt < nk; ++kt) {
    const bool more = (kt + 1 < nk);
    if (more) {
#pragma unroll
      for (int i = 0; i < 4; ++i) ra[i] = *(const uint4*)(ap[i] + (kt + 1) * BK);
#pragma unroll
      for (int i = 0; i < 2; ++i) rb[i] = *(const uint4*)(bp[i] + (kt + 1) * BK);
    }
    const u16* st = lds + (kt & 1) * STAGE;
    const u16* sa = st + (wm * 128 + (lane & 31)) * LROW + (lane >> 5) * 8;
    const u16* sb = st + A_BUF + (wn * 64 + (lane & 31)) * LROW + (lane >> 5) * 8;
#pragma unroll
    for (int ks = 0; ks < 2; ++ks) {
      bf16x8 af[4], bfr[2];
#pragma unroll
      for (int mb = 0; mb < 4; ++mb) af[mb] = *(const bf16x8*)(sa + mb * 32 * LROW + ks * 16);
#pragma unroll
      for (int nb = 0; nb < 2; ++nb) bfr[nb] = *(const bf16x8*)(sb + nb * 32 * LROW + ks * 16);
#pragma unroll
      for (int mb = 0; mb < 4; ++mb)
#pragma unroll
        for (int nb = 0; nb < 2; ++nb)
          acc[mb][nb] = __builtin_amdgcn_mfma_f32_32x32x16_bf16(af[mb], bfr[nb], acc[mb][nb], 0, 0, 0);
    }
    if (more) {
      u16* sw = lds + ((kt + 1) & 1) * STAGE;
#pragma unroll
      for (int i = 0; i < 4; ++i) *(uint4*)(sw + (r0 + 64 * i) * LROW + c4 * 8) = ra[i];
#pragma unroll
      for (int i = 0; i < 2; ++i) *(uint4*)(sw + A_BUF + (r0 + 64 * i) * LROW + c4 * 8) = rb[i];
    }
    __syncthreads();
  }
}


DEVI void epi_store_rm(const int TIDX, f32x16 (&acc)[4][2], u16* dst, long ld, long row0, int col0, bool GELU) {
  const int lane = TIDX & 63, wave = TIDX >> 6, wm = wave >> 1, wn = wave & 1;
#pragma unroll
  for (int mb = 0; mb < 4; ++mb)
#pragma unroll
    for (int nb = 0; nb < 2; ++nb)
#pragma unroll
      for (int rg = 0; rg < 4; ++rg)
#pragma unroll
        for (int i = 0; i < 4; ++i) {
          long row = row0 + wm * 128 + mb * 32 + rg * 8 + (lane >> 5) * 4 + i;
          int col = col0 + wn * 64 + nb * 32 + (lane & 31);
          float v = acc[mb][nb][rg * 4 + i];
          if (GELU) v = geluf_(v);
          dst[row * ld + col] = f2bf(v);
        }
}


#define LAS __attribute__((address_space(3)))
typedef unsigned u32x4 __attribute__((ext_vector_type(4)));
namespace pg8 {
constexpr int BM = 256, BK = 64, HALF = 128, HTB = HALF * BK * 2, STAGE_BYTES = 8 * HTB, NXCD = 8, WGM = 8;
DEVI int lds_byte(int r, int c) { const int st = (r >> 4) * 2 + (c >> 5), rr = r & 15, cc = c & 31, ob = rr * 64 + cc * 2; return st * 1024 + (ob ^ (((ob >> 9) & 1) << 5)); }
DEVI void stage_rc(int b, int& R, int& C) { const int st = b / 1024, sb = b % 1024, swz = sb ^ (((sb >> 9) & 1) << 5); R = (st >> 1) * 16 + swz / 64; C = (st & 1) * 32 + (swz % 64) / 2; }
DEVI int perm32(int rho) { const int n = rho >> 4, i = rho & 15; return 8 * (i >> 2) + 4 * n + (i & 3); }
struct Unit { int pm, pn; };
struct Gemm { const u16* A; const u16* Bt; int M, N, K; };
struct StaticOrder {
  int nM, nN, nwg, G, c;
  DEVI void init(int M, int N, int G_, int c_) { nM = M / BM; nN = N / BM; nwg = nM * nN; G = G_; c = c_; }
  DEVI bool next(int i, Unit& u) const {
    const long L = (long)i * G + c; if (L >= nwg) return false;
    int wgid = (int)L; { const int q = nwg / NXCD, r = nwg % NXCD, xcd = wgid % NXCD, off = wgid / NXCD; wgid = (xcd < r ? xcd * (q + 1) : r * (q + 1) + (xcd - r) * q) + off; }
    const int nig = WGM * nN, gid = wgid / nig, fm = gid * WGM, gsz = (nM - fm) < WGM ? (nM - fm) : WGM;
    u.pm = fm + ((wgid % nig) % gsz); u.pn = (wgid % nig) / gsz; return true;
  }
};
struct AddrPlain {
  const char *A, *B; unsigned rowA, rowB; size_t hA, hB;
  DEVI AddrPlain(const u16* A_, const u16* B_, int K) : A((const char*)A_), B((const char*)B_), rowA(K * 2), rowB(K * 2), hA((size_t)HALF * K * 2), hB((size_t)HALF * K * 2) {}
  DEVI const char* a(const Unit& u) const { return A + (size_t)u.pm * 2 * hA; }
  DEVI const char* b(const Unit& u) const { return B + (size_t)u.pn * 2 * hB; }
};
template <class Epi, class Addr>
DEVI void gemm_phase_ad(const int TIDX, LAS unsigned char* lds, const Gemm g, const Addr& ad, const Epi& E) {
  const int tid = TIDX, wid = __builtin_amdgcn_readfirstlane(tid >> 6), lane = tid & 63, wr = wid >> 2, wc = wid & 3, fr = lane & 15, fq = lane >> 4;
  const int K = g.K, nt = K / BK;
  StaticOrder S; S.init(g.M, g.N, (int)gridDim.x, (int)blockIdx.x);
  unsigned voffA[2], voffB[2];
#pragma unroll
  for (int i = 0; i < 2; ++i) { int R, C; stage_rc(tid * 16 + i * 8192, R, C); const int Rb = Epi::PERM ? ((R & ~31) + perm32(R & 31)) : R;
    voffA[i] = (unsigned)R * ad.rowA + (unsigned)C * 2u; voffB[i] = (unsigned)Rb * ad.rowB + (unsigned)C * 2u; }
  const size_t kstep = (size_t)(BK * 2);
  const size_t hstepA = ad.hA, hstepB = ad.hB;
  const unsigned ldsw = (unsigned)wid * 1024u;
  const int aoff = lds_byte(wr * 64 + fr, fq * 8), boff = lds_byte(wc * 32 + fr, fq * 8);
#define PG8_SA(b, h) (((b) * 2 + (h)) * HTB)
#define PG8_SB(b, h) ((4 + (b) * 2 + (h)) * HTB)
#define PG8_STAGE(bufoff, gbase, voff) do { _Pragma("unroll") for (int _i = 0; _i < 2; ++_i) \
    __builtin_amdgcn_global_load_lds((const unsigned*)((const char*)(gbase) + (voff)[_i]), (LAS unsigned*)(lds + (bufoff) + ldsw + _i * 8192), 16, 0, 0); } while (0)
#define PG8_LDA(dst, b, h) do { _Pragma("unroll") for (int m = 0; m < 4; ++m) _Pragma("unroll") for (int k = 0; k < 2; ++k) dst[m][k] = *(const LAS bf16x8*)(lds + PG8_SA(b, h) + aoff + m * 2048 + k * 1024); } while (0)
#define PG8_LDB(dst, b, h) do { _Pragma("unroll") for (int n = 0; n < 2; ++n) _Pragma("unroll") for (int k = 0; k < 2; ++k) dst[n][k] = *(const LAS bf16x8*)(lds + PG8_SB(b, h) + boff + n * 2048 + k * 1024); } while (0)
#define PG8_MMA(ai, bj, At, Bt) do { __builtin_amdgcn_s_setprio(1); _Pragma("unroll") for (int m = 0; m < 4; ++m) _Pragma("unroll") for (int n = 0; n < 2; ++n) _Pragma("unroll") for (int k = 0; k < 2; ++k) \
    acc[ai][bj][m][n] = __builtin_amdgcn_mfma_f32_16x16x32_bf16(Bt[n][k], At[m][k], acc[ai][bj][m][n], 0, 0, 0); __builtin_amdgcn_s_setprio(0); } while (0)
#define PG8_WAIT_V(n) asm volatile("s_waitcnt vmcnt(" #n ")" ::: "memory")
#define PG8_WAIT_L(n) asm volatile("s_waitcnt lgkmcnt(" #n ")" ::: "memory")
#define PG8_BAR __builtin_amdgcn_s_barrier()
#define PG8_SCHED __builtin_amdgcn_sched_barrier(0)
  Unit cur, nxt; int ui = 0;
  if (!S.next(0, cur)) return;
  f32x4 acc[2][2][4][2];
#pragma unroll
  for (int a = 0; a < 2; ++a)
#pragma unroll
    for (int b = 0; b < 2; ++b)
#pragma unroll
      for (int m = 0; m < 4; ++m)
#pragma unroll
        for (int n = 0; n < 2; ++n) acc[a][b][m][n] = (f32x4){0.f, 0.f, 0.f, 0.f};
  bf16x8 At[4][2], B0[2][2], B1[2][2];
  const char* cA = ad.a(cur); const char* cB = ad.b(cur);
  PG8_STAGE(PG8_SB(0, 0), cB, voffB); PG8_STAGE(PG8_SA(0, 0), cA, voffA); PG8_STAGE(PG8_SB(0, 1), cB + hstepB, voffB); PG8_STAGE(PG8_SA(0, 1), cA + hstepA, voffA);
  if (wr == 1) PG8_BAR;
  PG8_WAIT_V(4); PG8_BAR;
  PG8_STAGE(PG8_SB(1, 0), cB + kstep, voffB); PG8_STAGE(PG8_SA(1, 0), cA + kstep, voffA); PG8_STAGE(PG8_SB(1, 1), cB + hstepB + kstep, voffB);
  PG8_WAIT_V(6); PG8_BAR;
  for (;;) {
    const bool has_next = S.next(ui + 1, nxt);
    const char* nA = has_next ? ad.a(nxt) : cA; const char* nB = has_next ? ad.b(nxt) : cB;
    const typename Epi::Pre pre = E.prefetch(cur, wr, fr);
    for (int t = 0; t < nt; t += 2) {
      const bool last = (t == nt - 2);
      const char* a1 = cA + (size_t)(t + 1) * kstep;
      const char* a2 = last ? nA : cA + (size_t)(t + 2) * kstep; const char* b2 = last ? nB : cB + (size_t)(t + 2) * kstep;
      const char* a3 = a2 + kstep; const char* b3 = b2 + kstep;
      PG8_LDB(B0, 0, 0); PG8_SCHED; PG8_LDA(At, 0, 0); PG8_STAGE(PG8_SA(1, 1), a1 + hstepA, voffA);
      PG8_WAIT_L(8); PG8_BAR; PG8_WAIT_L(0); PG8_MMA(0, 0, At, B0); PG8_BAR; PG8_SCHED;
      PG8_LDB(B1, 0, 1); PG8_STAGE(PG8_SB(0, 0), b2, voffB);
      PG8_BAR; PG8_WAIT_L(0); PG8_MMA(0, 1, At, B1); PG8_BAR;
      PG8_LDA(At, 0, 1); PG8_STAGE(PG8_SA(0, 0), a2, voffA);
      PG8_BAR; PG8_WAIT_L(0); PG8_MMA(1, 0, At, B0); PG8_BAR; PG8_SCHED;
      PG8_STAGE(PG8_SB(0, 1), b2 + hstepB, voffB);
      PG8_WAIT_V(6); PG8_BAR; PG8_MMA(1, 1, At, B1); PG8_BAR;
      PG8_LDB(B0, 1, 0); PG8_SCHED; PG8_LDA(At, 1, 0); PG8_STAGE(PG8_SA(0, 1), a2 + hstepA, voffA);
      PG8_WAIT_L(8); PG8_BAR; PG8_WAIT_L(0); PG8_MMA(0, 0, At, B0); PG8_BAR; PG8_SCHED;
      PG8_LDB(B1, 1, 1); PG8_STAGE(PG8_SB(1, 0), b3, voffB);
      PG8_BAR; PG8_WAIT_L(0); PG8_MMA(0, 1, At, B1); PG8_BAR;
      PG8_LDA(At, 1, 1); PG8_STAGE(PG8_SA(1, 0), a3, voffA);
      PG8_BAR; PG8_WAIT_L(0); PG8_MMA(1, 0, At, B0); PG8_BAR; PG8_SCHED;
      PG8_STAGE(PG8_SB(1, 1), b3 + hstepB, voffB);
      PG8_WAIT_V(6); PG8_BAR; PG8_MMA(1, 1, At, B1); PG8_BAR;
    }
    E(acc, cur, wr, wc, fr, fq, pre);
    if (!has_next) break;
#pragma unroll
    for (int a = 0; a < 2; ++a)
#pragma unroll
      for (int b = 0; b < 2; ++b)
#pragma unroll
        for (int m = 0; m < 4; ++m)
#pragma unroll
          for (int n = 0; n < 2; ++n) acc[a][b][m][n] = (f32x4){0.f, 0.f, 0.f, 0.f};
    cur = nxt; cA = nA; cB = nB; ++ui;
  }
  PG8_WAIT_V(0);
  if (wr == 0) PG8_BAR;
  PG8_BAR;
#undef PG8_SA
#undef PG8_SB
#undef PG8_STAGE
#undef PG8_LDA
#undef PG8_LDB
#undef PG8_MMA
#undef PG8_WAIT_V
#undef PG8_WAIT_L
#undef PG8_BAR
#undef PG8_SCHED
}
template <class Epi>
DEVI void gemm_phase(const int TIDX, LAS unsigned char* lds, const Gemm g, const Epi& E) {
  AddrPlain ad(g.A, g.Bt, g.K);
  gemm_phase_ad(TIDX, lds, g, ad, E);
}
struct PreNone {};
struct PreRows { float s[2][4]; };
struct EpiSwiglu {
  static constexpr bool PERM = true;
  u16* act; const float* stat;
  typedef PreRows Pre;
  DEVI Pre prefetch(const Unit& u, int wr, int fr) const {
    Pre q;
#pragma unroll
    for (int ai = 0; ai < 2; ++ai)
#pragma unroll
      for (int m = 0; m < 4; ++m) q.s[ai][m] = stat[u.pm * BM + wr * 64 + fr + ai * HALF + m * 16];
    return q;
  }
  DEVI void operator()(const f32x4 (&acc)[2][2][4][2], const Unit& u, int wr, int wc, int fr, int fq, const Pre& pre) const {
    const int row0 = u.pm * BM + wr * 64 + fr, col0 = u.pn * 128 + wc * 32 + 8 * fq;
#pragma unroll
    for (int ai = 0; ai < 2; ++ai)
#pragma unroll
      for (int m = 0; m < 4; ++m) {
        const int row = row0 + ai * HALF + m * 16;
        const float r = rsqrtf(pre.s[ai][m] * (1.f / 1024.f) + EPS);
        const float rn = -1.4426950408889634f * r, rr = r * r;
        f32x4 o0, o1;
#pragma unroll
        for (int j = 0; j < 4; ++j) {
          const float g0 = acc[ai][0][m][0][j], g1 = acc[ai][0][m][1][j];
          o0[j] = (g0 * acc[ai][1][m][0][j]) * (rr * __builtin_amdgcn_rcpf(1.f + __builtin_amdgcn_exp2f(g0 * rn)));
          o1[j] = (g1 * acc[ai][1][m][1][j]) * (rr * __builtin_amdgcn_rcpf(1.f + __builtin_amdgcn_exp2f(g1 * rn)));
        }
        u32x4 w; w.x = pack2(o0[0], o0[1]); w.y = pack2(o0[2], o0[3]); w.z = pack2(o1[0], o1[1]); w.w = pack2(o1[2], o1[3]);
        __builtin_nontemporal_store(w, (u32x4*)(act + (size_t)row * FF + col0));
      }
  }
};
struct EpiStore {
  static constexpr bool PERM = true;
  u16* O; int ldc; int gelu_pn; const float* stat;
  typedef PreRows Pre;
  DEVI Pre prefetch(const Unit& u, int wr, int fr) const {
    Pre q;
#pragma unroll
    for (int ai = 0; ai < 2; ++ai)
#pragma unroll
      for (int m = 0; m < 4; ++m) q.s[ai][m] = stat ? stat[u.pm * BM + wr * 64 + fr + ai * HALF + m * 16] : 0.f;
    return q;
  }
  DEVI void operator()(const f32x4 (&acc)[2][2][4][2], const Unit& u, int wr, int wc, int fr, int fq, const Pre& pre) const {
    const int row0 = u.pm * BM + wr * 64 + fr, col0 = u.pn * BM + wc * 32 + 8 * fq;
    const bool ge = u.pn < gelu_pn;
#pragma unroll
    for (int ai = 0; ai < 2; ++ai)
#pragma unroll
      for (int m = 0; m < 4; ++m) {
        const int row = row0 + ai * HALF + m * 16;
        const float r = stat ? rsqrtf(pre.s[ai][m] * (1.f / 1024.f) + EPS) : 1.f;
        u16* rowp = O + (size_t)row * ldc + col0;
#pragma unroll
        for (int bj = 0; bj < 2; ++bj) {
          f32x4 v0 = acc[ai][bj][m][0] * r, v1 = acc[ai][bj][m][1] * r;
          if (ge) {
#pragma unroll
            for (int j = 0; j < 4; ++j) { v0[j] = geluf_(v0[j]); v1[j] = geluf_(v1[j]); }
          }
          u32x4 w; w.x = pack2(v0[0], v0[1]); w.y = pack2(v0[2], v0[3]); w.z = pack2(v1[0], v1[1]); w.w = pack2(v1[2], v1[3]);
          *(u32x4*)(rowp + bj * HALF) = w;
        }
      }
  }
};
template <bool SAMPLE>
struct AddrF1 {
  const char *A, *H; unsigned rowA, rowB; size_t hA, hB;
  DEVI AddrF1(const u16* T1, const u16* H_) : A((const char*)T1), H((const char*)H_), rowA(512), rowB((SAMPLE ? 16 : 128) * 2048), hA((size_t)128 * 512), hB(2048) {}
  DEVI const char* a(const Unit& u) const { const int g = SAMPLE ? (u.pn >> 7) : (u.pn >> 6); return A + (size_t)g * 512 * 512 + (size_t)u.pm * 256 * 512; }
  DEVI const char* b(const Unit& u) const {
    if (SAMPLE) { const int g = u.pn >> 7, bb = (u.pn >> 3) & 15, pair = u.pn & 7; return H + ((size_t)(TP + bb * 2048 + 2 * pair) * 1024 + g * 256) * 2; }
    const int g = u.pn >> 6, pair = u.pn & 63; return H + ((size_t)(2 * pair) * 1024 + g * 256) * 2;
  }
};
template <bool SAMPLE>
struct EpiF1 {
  static constexpr bool PERM = false;
  u16* Zt;
  typedef PreNone Pre;
  DEVI Pre prefetch(const Unit&, int, int) const { return Pre{}; }
  DEVI void operator()(const f32x4 (&acc)[2][2][4][2], const Unit& u, int wr, int wc, int fr, int fq, const Pre&) const {
    const int s = u.pm;
    const int g = SAMPLE ? (u.pn >> 7) : (u.pn >> 6);
    const int bb = (u.pn >> 3) & 15;
    const int pair = SAMPLE ? (u.pn & 7) : (u.pn & 63);
#pragma unroll
    for (int ai = 0; ai < 2; ++ai)
#pragma unroll
      for (int m = 0; m < 4; ++m) {
        const int cp = g * 256 + 128 * ai + 64 * wr + 16 * m + fr;
#pragma unroll
        for (int bj = 0; bj < 2; ++bj) {
          const int n2 = 2 * pair + bj;
          const long rowz = SAMPLE ? (((long)cp * 16 + bb) * 16 + n2) : ((long)cp * 128 + n2);
          u16* dst = Zt + (rowz * 2 + s) * 128 + 32 * wc + 4 * fq;
#pragma unroll
          for (int n = 0; n < 2; ++n) {
            const f32x4 v = acc[ai][bj][m][n];
            uint2 o; o.x = pack2(v[0], v[1]); o.y = pack2(v[2], v[3]);
            *(uint2*)(dst + 16 * n) = o;
          }
        }
      }
  }
};
template <bool SAMPLE>
struct EpiFA {
  static constexpr bool PERM = false;
  u16* Yt;
  typedef PreNone Pre;
  DEVI Pre prefetch(const Unit&, int, int) const { return Pre{}; }
  DEVI void operator()(const f32x4 (&acc)[2][2][4][2], const Unit& u, int wr, int wc, int fr, int fq, const Pre&) const {
    constexpr float W = SAMPLE ? (6.283185307179586f / 2048.f) : (6.283185307179586f / 16384.f);
#pragma unroll
    for (int m = 0; m < 4; ++m) {
      int k1 = 64 * wr + 16 * m + fr;
      asm volatile("" : "+v"(k1));
#pragma unroll
      for (int n = 0; n < 2; ++n) {
        const int n2 = SAMPLE ? 4 * fq : (32 * wc + 16 * n + 4 * fq);
        float ct[4], st[4];
#pragma unroll
        for (int j = 0; j < 4; ++j) {
          const float ang = (float)((n2 + j) * k1) * W;
          ct[j] = __cosf(ang);
          st[j] = __sinf(ang);
        }
#pragma unroll
        for (int bj = 0; bj < 2; ++bj) {
          unsigned off;
          if (SAMPLE) off = ((unsigned)((8 * bj + 2 * wc + n) * 128 + k1) * 1024u + (unsigned)u.pn) * 32u + (unsigned)n2;
          else off = (unsigned)k1 * 262144u + (unsigned)(2 * u.pn + bj) * 256u + (unsigned)n2;
          const f32x4 re = acc[0][bj][m][n], im = acc[1][bj][m][n];
          uint2 o;
          o.x = pack2(re[0] * ct[0] + im[0] * st[0], re[1] * ct[1] + im[1] * st[1]);
          o.y = pack2(re[2] * ct[2] + im[2] * st[2], re[3] * ct[3] + im[3] * st[3]);
          *(uint2*)(Yt + off) = o;
          o.x = pack2(im[0] * ct[0] - re[0] * st[0], im[1] * ct[1] - re[1] * st[1]);
          o.y = pack2(im[2] * ct[2] - re[2] * st[2], im[3] * ct[3] - re[3] * st[3]);
          *(uint2*)(Yt + off + (SAMPLE ? 16 : 128)) = o;
        }
        __builtin_amdgcn_sched_barrier(0);
      }
    }
  }
};
}

template <bool SAMPLE>
DEVI void phase_f1_pg8(const int TIDX, const Params& p, LAS unsigned char* ldsl) {
  pg8::Gemm g{nullptr, nullptr, 512, SAMPLE ? 131072 : 65536, 256};
  pg8::AddrF1<SAMPLE> ad((const u16*)(p.ws + WS_T1), (const u16*)(p.ws + WS_H));
  pg8::EpiF1<SAMPLE> E{(u16*)(p.ws + WS_BIG) + (SAMPLE ? (size_t)131072 * 256 : 0)};
  pg8::gemm_phase_ad(TIDX, ldsl, g, ad, E);
}
template <bool SAMPLE>
DEVI void phase_fa_pg8(const int TIDX, const Params& p, LAS unsigned char* ldsl) {
  pg8::Gemm g{(const u16*)(p.ws + WS_T2), (const u16*)(p.ws + WS_BIG) + (SAMPLE ? (size_t)131072 * 256 : 0), 256, SAMPLE ? 262144 : 131072, 256};
  pg8::EpiFA<SAMPLE> E{(u16*)p.out + (SAMPLE ? (size_t)131072 * 256 : 0)};
  pg8::gemm_phase(TIDX, ldsl, g, E);
}


DEVI void phase_g1(const int TIDX, const Params& p, int f, LAS unsigned char* ldsl) {
  pg8::Gemm g{(const u16*)(p.ws + WS_XB), (const u16*)(p.ws + WS_WGU) + (size_t)(f & 1) * 5632 * 1024, T, 5632, 1024};
  pg8::EpiSwiglu E{(u16*)(p.ws + WS_BIG), (const float*)(p.ws + WS_STAT)};
  pg8::gemm_phase(TIDX, ldsl, g, E);
}
DEVI void phase_g2(const int TIDX, const Params& p, int f, LAS unsigned char* ldsl) {
  pg8::Gemm g{(const u16*)(p.ws + WS_BIG), (const u16*)(p.ws + WS_WD) + (size_t)(f & 1) * 1024 * 2816, T, 1024, FF};
  pg8::EpiStore E{(u16*)(p.ws + WS_H), 1024, 0, nullptr};
  pg8::gemm_phase(TIDX, ldsl, g, E);
}
DEVI void phase_gin(const int TIDX, const Params& p, LAS unsigned char* ldsl) {
  pg8::Gemm g{(const u16*)(p.ws + WS_XB), (const u16*)(p.ws + WS_WIN), T, 2048, 1024};
  pg8::EpiStore E{(u16*)(p.ws + WS_BIG), 2048, 4, (const float*)(p.ws + WS_STAT)};
  pg8::gemm_phase(TIDX, ldsl, g, E);
}
DEVI void phase_gout(const int TIDX, const Params& p, int layer, LAS unsigned char* ldsl) {
  pg8::Gemm g{(const u16*)(p.ws + WS_H), (const u16*)(p.ws + WS_WOUT) + (size_t)layer * 1024 * 1024, T, 1024, 1024};
  pg8::EpiStore E{(u16*)(p.ws + WS_BIG), 1024, 0, nullptr};
  pg8::gemm_phase(TIDX, ldsl, g, E);
}

DEVI void phase_sgu(const int TIDX, const Params& p, u16* lds) {
  const int SB = TIDX >> 8, TID = TIDX & 255;
  lds += SB * 32768;
  const u16* vt = (const u16*)(p.ws + WS_BIG) + (size_t)T * 2048;
  const u16* sgw = (const u16*)(p.ws + WS_SGW);
  const u16* proj = (const u16*)(p.ws + WS_BIG);
  u16* cat = (u16*)(p.ws + WS_H);
  const int ntiles = 768;
  const int lane = TID & 63, wave = TID >> 6, wm = wave >> 1, wn = wave & 1;
  for (int t = 2 * blockIdx.x + SB; t < ntiles; t += 2 * gridDim.x) {
    int mt, nt;
    tile_map(t, 1, mt, nt);
    const int head = mt / 192;
    f32x16 acc[4][2];
    const long arow0 = (long)mt * 256;
    gemm_mainloop(TID, vt, [=](int r) { return (arow0 + r) * 128; }, sgw + head * 128 * 128, 128, 128, lds, acc);
#pragma unroll
    for (int nb = 0; nb < 2; ++nb) {
      const int q = wn * 64 + nb * 32 + (lane & 31);
      const float bias = p.sg_b[head * 128 + q];
#pragma unroll
      for (int mb = 0; mb < 4; ++mb)
#pragma unroll
        for (int rg = 0; rg < 4; ++rg) {
          int rh = (mt % 192) * 256 + wm * 128 + mb * 32 + rg * 8 + (lane >> 5) * 4;
          int chunk = rh >> 7, c = rh & 127;
          long token = (long)chunk * 128 + q;
          uint2 uv = *(const uint2*)(proj + token * 2048 + head * 128 + c);
          float o0 = (acc[mb][nb][rg * 4 + 0] + bias) * bf_lo(uv.x);
          float o1 = (acc[mb][nb][rg * 4 + 1] + bias) * bf_hi(uv.x);
          float o2 = (acc[mb][nb][rg * 4 + 2] + bias) * bf_lo(uv.y);
          float o3 = (acc[mb][nb][rg * 4 + 3] + bias) * bf_hi(uv.y);
          uint2 ov;
          ov.x = pack2(o0, o1);
          ov.y = pack2(o2, o3);
          *(uint2*)(cat + token * 1024 + head * 128 + c) = ov;
        }
    }
  }
}

template <bool SAMPLE>
DEVI void phase_f1(const int TIDX, const Params& p, u16* lds) {
  const int SB = TIDX >> 8, TID = TIDX & 255;
  lds += SB * 32768;
  const u16* H = (const u16*)(p.ws + WS_H);
  const u16* T1 = (const u16*)(p.ws + WS_T1);
  u16* Zt = (u16*)(p.ws + WS_BIG);
  const int NT = 16, MT = SAMPLE ? 128 : 64, ntiles = MT * NT;
  const int lane = TID & 63, wave = TID >> 6, wm = wave >> 1, wn = wave & 1;
  for (int t = 2 * blockIdx.x + SB; t < ntiles; t += 2 * gridDim.x) {
    int mt, nt;
    tile_map(t, NT, mt, nt);
    const int g = nt >> 2, nq = nt & 3;
    f32x16 acc[4][2];
    if (SAMPLE) {
      const long tb = TP + (long)(mt >> 3) * 2048 + 2 * (mt & 7);
      gemm_mainloop(TID, H, [=](int r) { return (tb + (long)(r & 127) * 16 + (r >> 7)) * 1024 + g * 256; },
                    T1 + (size_t)nq * 128 * 256, 256, 256, lds, acc);
    } else {
      const long tb = 2 * mt;
      gemm_mainloop(TID, H, [=](int r) { return (tb + (long)(r & 127) * 128 + (r >> 7)) * 1024 + g * 256; },
                    T1 + (size_t)nq * 128 * 256, 256, 256, lds, acc);
    }
    const int s = nq >> 1;
#pragma unroll
    for (int nb = 0; nb < 2; ++nb) {
      const int cp = g * 256 + (nq & 1) * 128 + wn * 64 + nb * 32 + (lane & 31);
      long rowz;
      if (SAMPLE) rowz = ((long)cp * 16 + (mt >> 3)) * 16 + 2 * (mt & 7) + wm;
      else rowz = (long)cp * 128 + 2 * mt + wm;
      u16* dst = Zt + (rowz * 2 + s) * 128;
#pragma unroll
      for (int mb = 0; mb < 4; ++mb)
#pragma unroll
        for (int rg = 0; rg < 4; ++rg) {
          int n1 = mb * 32 + rg * 8 + (lane >> 5) * 4;
          uint2 ov;
          ov.x = pack2(acc[mb][nb][rg * 4 + 0], acc[mb][nb][rg * 4 + 1]);
          ov.y = pack2(acc[mb][nb][rg * 4 + 2], acc[mb][nb][rg * 4 + 3]);
          *(uint2*)(dst + n1) = ov;
        }
    }
  }
}

template <bool SAMPLE>
DEVI void phase_fa(const int TIDX, const Params& p, u16* lds) {
  const int SB = TIDX >> 8, TID = TIDX & 255;
  lds += SB * 32768;
  const u16* Zt = (const u16*)(p.ws + WS_BIG);
  const u16* T2 = (const u16*)(p.ws + WS_T2);
  u16* Yt = (u16*)(p.ws + WS_BIG) + (SAMPLE ? (size_t)262144 * 256 : (size_t)131072 * 256);
  const int NT = 2, MT = SAMPLE ? 1024 : 512, ntiles = MT * NT;
  const int lane = TID & 63, wave = TID >> 6, wm = wave >> 1, wn = wave & 1;
  for (int t = 2 * blockIdx.x + SB; t < ntiles; t += 2 * gridDim.x) {
    int mt, nt;
    tile_map(t, NT, mt, nt);
    f32x16 acc[4][2];
    const long arow0 = (long)mt * 256;
    gemm_mainloop(TID, Zt, [=](int r) { return (arow0 + r) * 256; }, T2 + (size_t)nt * 128 * 256, 256, 256, lds, acc);
    const int k1 = 32 * (nt * 2 + wn) + (lane & 31);
#pragma unroll
    for (int mb = 0; mb < 4; ++mb)
#pragma unroll
      for (int rg = 0; rg < 4; ++rg) {
        const long row = arow0 + wm * 128 + mb * 32 + rg * 8 + (lane >> 5) * 4;
        float yr[4], yi[4];
        int n2;
        u16 *dre, *dim_;
        if (SAMPLE) {
          n2 = (int)(row & 15);
          int b = (int)((row >> 4) & 15);
          int cp = (int)(row >> 8);
          u16* base = Yt + ((((long)b * 128 + k1) * 1024 + cp) * 2) * 16 + n2;
          dre = base;
          dim_ = base + 16;
        } else {
          n2 = (int)(row & 127);
          int cp = (int)(row >> 7);
          u16* base = Yt + (((long)k1 * 1024 + cp) * 2) * 128 + n2;
          dre = base;
          dim_ = base + 128;
        }
#pragma unroll
        for (int i = 0; i < 4; ++i) {
          float re = acc[mb][0][rg * 4 + i], im = acc[mb][1][rg * 4 + i];
          float ang = (float)((n2 + i) * k1) * (SAMPLE ? (6.283185307179586f / 2048.f) : (6.283185307179586f / 16384.f));
          float ct = __cosf(ang), st = __sinf(ang);
          yr[i] = re * ct + im * st;
          yi[i] = im * ct - re * st;
        }
        uint2 o;
        o.x = pack2(yr[0], yr[1]);
        o.y = pack2(yr[2], yr[3]);
        *(uint2*)dre = o;
        o.x = pack2(yi[0], yi[1]);
        o.y = pack2(yi[2], yi[3]);
        *(uint2*)dim_ = o;
      }
  }
}

DEVI void phase_fb_prompt(const int TIDX, const Params& p, u16* lds) {
  const int SB = TIDX >> 8, TID = TIDX & 255;
  lds += SB * 32768;
  const u16* Yt = (const u16*)p.out;
  const u16* T3 = (const u16*)(p.ws + WS_T3);
  u16* f = (u16*)(p.ws + WS_H);
  const int ntiles = 512;
  const int lane = TID & 63, wave = TID >> 6, wm = wave >> 1, wn = wave & 1;
  for (int t = 2 * blockIdx.x + SB; t < ntiles; t += 2 * gridDim.x) {
    int mt, nt;
    tile_map(t, 1, mt, nt);
    f32x16 acc[4][2];
    const long arow0 = (long)mt * 256;
    gemm_mainloop(TID, Yt, [=](int r) { return (arow0 + r) * 256; }, T3, 256, 256, lds, acc);
#pragma unroll
    for (int nb = 0; nb < 2; ++nb) {
      const int k2 = wn * 64 + nb * 32 + (lane & 31);
#pragma unroll
      for (int mb = 0; mb < 4; ++mb)
#pragma unroll
        for (int rg = 0; rg < 4; ++rg) {
          long row = arow0 + wm * 128 + mb * 32 + rg * 8 + (lane >> 5) * 4;
          int k1 = (int)(row >> 10), cp = (int)(row & 1023);
          long token = k1 + 128 * k2;
          uint2 o;
          o.x = pack2(acc[mb][nb][rg * 4 + 0], acc[mb][nb][rg * 4 + 1]);
          o.y = pack2(acc[mb][nb][rg * 4 + 2], acc[mb][nb][rg * 4 + 3]);
          *(uint2*)(f + token * 1024 + cp) = o;
        }
    }
  }
}

DEVI void phase_fb_sample(const int TIDX, const Params& p) {
  const u16* Yt = (const u16*)p.out + (size_t)131072 * 256;
  u16* f = (u16*)(p.ws + WS_H);
  const int lane = TIDX & 63, wave = TIDX >> 6;
  const int col = lane & 15, kg = lane >> 4;
  bf16x8 bfrag;
#pragma unroll
  for (int j = 0; j < 8; ++j) {
    int k = kg * 8 + j, s = k >> 4, n2 = k & 15;
    int ph = (col * n2) & 15;
    float v = (s == 0 ? cospif((float)ph * 0.125f) : sinpif((float)ph * 0.125f)) * 0.25f;
    bfrag[j] = (short)f2bf(v);
  }
  const int G = 131072;
  const int nw = gridDim.x * 8;
  for (int g0 = blockIdx.x * 8 + wave; g0 < G; g0 += 4 * nw) {
    bf16x8 afrag[4];
#pragma unroll
    for (int i = 0; i < 4; ++i) {
      const long row0 = (long)(g0 + i * nw) * 16;
      afrag[i] = *(const bf16x8*)(Yt + (row0 + (lane & 15)) * 32 + kg * 8);
    }
#pragma unroll
    for (int i = 0; i < 4; ++i) {
      f32x4 acc = {0.f, 0.f, 0.f, 0.f};
      acc = __builtin_amdgcn_mfma_f32_16x16x32_bf16(afrag[i], bfrag, acc, 0, 0, 0);
      const long row = (long)(g0 + i * nw) * 16 + 4 * kg;
      const int cp = (int)(row & 1023), k1 = (int)((row >> 10) & 127), b = (int)(row >> 17);
      const long token = TP + (long)b * 2048 + k1 + 128 * col;
      uint2 o;
      o.x = pack2(acc[0], acc[1]);
      o.y = pack2(acc[2], acc[3]);
      *(uint2*)(f + token * 1024 + cp) = o;
    }
  }
}

DEVI void phase_norm(const int TIDX, const Params& p, int mode, const u16* y, float scale, const float* post_g) {
  u16* xb = (u16*)(p.ws + WS_XB);
  float* stat = (float*)(p.ws + WS_STAT);
  const int lane = TIDX & 63, wave = TIDX >> 6;
  const int stride = gridDim.x * 8;
  int row = blockIdx.x * 8 + wave;
  if (mode == 0) {
    for (; row < T; row += stride) {
      const float* xsrc = row < TP ? p.xp + (long)row * 1024 : p.xs + (long)(row - TP) * 1024;
      float ss = 0.f;
#pragma unroll
      for (int j = 0; j < 2; ++j) {
        const float4 a = *(const float4*)(xsrc + j * 512 + lane * 8), b = *(const float4*)(xsrc + j * 512 + lane * 8 + 4);
        ss += a.x * a.x + a.y * a.y + a.z * a.z + a.w * a.w + b.x * b.x + b.y * b.y + b.z * b.z + b.w * b.w;
        uint4 o;
        o.x = pack2(a.x, a.y); o.y = pack2(a.z, a.w); o.z = pack2(b.x, b.y); o.w = pack2(b.z, b.w);
        *(uint4*)(xb + (long)row * 1024 + j * 512 + lane * 8) = o;
      }
      ss = wave_sum(ss, lane);
      if (lane == 0) stat[row] = ss;
    }
    return;
  }
  float gp[2][8];
#pragma unroll
  for (int j = 0; j < 2; ++j) {
    const float4 g0 = *(const float4*)(post_g + j * 512 + lane * 8), g1 = *(const float4*)(post_g + j * 512 + lane * 8 + 4);
    gp[j][0] = g0.x * scale; gp[j][1] = g0.y * scale; gp[j][2] = g0.z * scale; gp[j][3] = g0.w * scale;
    gp[j][4] = g1.x * scale; gp[j][5] = g1.y * scale; gp[j][6] = g1.z * scale; gp[j][7] = g1.w * scale;
  }
  uint4 yv[2], xr[2];
  if (row < T) {
#pragma unroll
    for (int j = 0; j < 2; ++j) {
      yv[j] = *(const uint4*)(y + (long)row * 1024 + j * 512 + lane * 8);
      xr[j] = *(const uint4*)(xb + (long)row * 1024 + j * 512 + lane * 8);
    }
  }
  while (row < T) {
    const int nrow = row + stride;
    uint4 yn[2], xn[2];
    if (nrow < T) {
#pragma unroll
      for (int j = 0; j < 2; ++j) {
        yn[j] = *(const uint4*)(y + (long)nrow * 1024 + j * 512 + lane * 8);
        xn[j] = *(const uint4*)(xb + (long)nrow * 1024 + j * 512 + lane * 8);
      }
    } else {
#pragma unroll
      for (int j = 0; j < 2; ++j) { yn[j] = yv[j]; xn[j] = xr[j]; }
    }
    float xv[2][8], yf[2][8];
    float ss = 0.f;
#pragma unroll
    for (int j = 0; j < 2; ++j) {
      yf[j][0] = bf_lo(yv[j].x); yf[j][1] = bf_hi(yv[j].x); yf[j][2] = bf_lo(yv[j].y); yf[j][3] = bf_hi(yv[j].y);
      yf[j][4] = bf_lo(yv[j].z); yf[j][5] = bf_hi(yv[j].z); yf[j][6] = bf_lo(yv[j].w); yf[j][7] = bf_hi(yv[j].w);
      xv[j][0] = bf_lo(xr[j].x); xv[j][1] = bf_hi(xr[j].x); xv[j][2] = bf_lo(xr[j].y); xv[j][3] = bf_hi(xr[j].y);
      xv[j][4] = bf_lo(xr[j].z); xv[j][5] = bf_hi(xr[j].z); xv[j][6] = bf_lo(xr[j].w); xv[j][7] = bf_hi(xr[j].w);
#pragma unroll
      for (int e = 0; e < 8; ++e) ss += yf[j][e] * yf[j][e];
    }
    ss = wave_sum(ss, lane);
    const float r = rsqrtf(ss * (1.f / 1024.f) + EPS);
    float sx = 0.f;
#pragma unroll
    for (int j = 0; j < 2; ++j)
#pragma unroll
      for (int e = 0; e < 8; ++e) {
        xv[j][e] += yf[j][e] * r * gp[j][e];
        sx += xv[j][e] * xv[j][e];
      }
    if (mode == 2) {
#pragma unroll
      for (int j = 0; j < 2; ++j) {
        float4 a, b;
        a.x = xv[j][0]; a.y = xv[j][1]; a.z = xv[j][2]; a.w = xv[j][3]; b.x = xv[j][4]; b.y = xv[j][5]; b.z = xv[j][6]; b.w = xv[j][7];
        *(float4*)(p.out + (long)row * 1024 + j * 512 + lane * 8) = a;
        *(float4*)(p.out + (long)row * 1024 + j * 512 + lane * 8 + 4) = b;
      }
    } else {
#pragma unroll
      for (int j = 0; j < 2; ++j) {
        uint4 o;
        o.x = pack2(xv[j][0], xv[j][1]); o.y = pack2(xv[j][2], xv[j][3]); o.z = pack2(xv[j][4], xv[j][5]); o.w = pack2(xv[j][6], xv[j][7]);
        *(uint4*)(xb + (long)row * 1024 + j * 512 + lane * 8) = o;
      }
      sx = wave_sum(sx, lane);
      if (lane == 0) stat[row] = sx;
      if (mode == 3) {
        const float rx = rsqrtf(sx * (1.f / 1024.f) + EPS);
        u16* hrow = (u16*)(p.ws + WS_H) + (long)row * 1024;
#pragma unroll
        for (int j = 0; j < 2; ++j) {
          uint4 o;
          o.x = pack2(xv[j][0] * rx, xv[j][1] * rx); o.y = pack2(xv[j][2] * rx, xv[j][3] * rx);
          o.z = pack2(xv[j][4] * rx, xv[j][5] * rx); o.w = pack2(xv[j][6] * rx, xv[j][7] * rx);
          *(uint4*)(hrow + j * 512 + lane * 8) = o;
        }
      }
    }
#pragma unroll
    for (int j = 0; j < 2; ++j) { yv[j] = yn[j]; xr[j] = xn[j]; }
    row = nrow;
  }
}

DEVI void tconv_tile(const int TIDX, const float* __restrict__ src, int ldsrc, u16* __restrict__ dst, int lddst, int k0, int n0, int rm,
                     float* tl, const float* __restrict__ kscale) {
  const int tid = TIDX;
  {
    const int nn4 = (tid & 15) * 4, kk = tid >> 4;
#pragma unroll
    for (int i = 0; i < 4; ++i) {
      float4 v = *(const float4*)(src + (long)(k0 + kk + 16 * i) * ldsrc + n0 + nn4);
      const float ks = kscale ? kscale[k0 + kk + 16 * i] : 1.f;
      float* d = tl + (kk + 16 * i) * 65 + nn4;
      d[0] = v.x * ks; d[1] = v.y * ks; d[2] = v.z * ks; d[3] = v.w * ks;
    }
  }
  __syncthreads();
  {
    const int kk8 = (tid & 7) * 8, nn = tid >> 3;
#pragma unroll
    for (int i = 0; i < 2; ++i) {
      int n = nn + 32 * i;
      float v[8];
#pragma unroll
      for (int j = 0; j < 8; ++j) v[j] = tl[(kk8 + j) * 65 + n];
      uint4 o;
      o.x = pack2(v[0], v[1]); o.y = pack2(v[2], v[3]); o.z = pack2(v[4], v[5]); o.w = pack2(v[6], v[7]);
      int ng = n0 + n;
      int drow = (rm == 0) ? ng : (256 * (ng >> 7) + (ng & 127) + (rm == 2 ? 128 : 0));
      *(uint4*)(dst + (long)drow * lddst + k0 + kk8) = o;
    }
  }
  __syncthreads();
}

DEVI void prep_ffn_tile(const int TID, const Params& p, int f, int t, float* tl) {
  const int kind = t / 704, tt = t - kind * 704, j = f & 1;
  if (kind < 2) {
    const float* src = (kind ? p.w_up : p.w_gate) + (size_t)f * 1024 * 2816;
    u16* dst = (u16*)(p.ws + WS_WGU) + (size_t)j * 5632 * 1024;
    tconv_tile(TID, src, 2816, dst, 1024, (tt & 15) * 64, (tt >> 4) * 64, kind ? 2 : 1, tl, p.ffn_pre_g + f * 1024);
  } else {
    const float* src = p.w_down + (size_t)f * 2816 * 1024;
    u16* dst = (u16*)(p.ws + WS_WD) + (size_t)j * 1024 * 2816;
    tconv_tile(TID, src, 1024, dst, 2816, (tt % 44) * 64, (tt / 44) * 64, 0, tl, nullptr);
  }
}
DEVI void prep_ffn_in_tail(const int TIDX, const Params& p, int f, float* tl) {
  if (blockIdx.x < 128 || gridDim.x != 256) return;
  const int SB = TIDX >> 8, TID = TIDX & 255;
  tl += SB * 16384;
  for (int t = 2 * ((int)blockIdx.x - 128) + SB; t < 2112; t += 256) prep_ffn_tile(TID, p, f, t, tl);
}
DEVI void prep_ffn_all(const int TIDX, const Params& p, int f, float* tl) {
  const int SB = TIDX >> 8, TID = TIDX & 255;
  tl += SB * 16384;
  for (int t = 2 * blockIdx.x + SB; t < 2112; t += 2 * gridDim.x) prep_ffn_tile(TID, p, f, t, tl);
}
DEVI void phase_prep(const int TIDX, const Params& p, float* tl) {
  const int SB = TIDX >> 8, TID = TIDX & 255;
  tl += SB * 16384;
  const int ntiles = 2112 + 512 + 512;
  for (int t = 2 * blockIdx.x + SB; t < ntiles; t += 2 * gridDim.x) {
    if (t < 2112) {
      prep_ffn_tile(TID, p, 0, t, tl);
    } else if (t < 2624) {
      int tt = t - 2112;
      tconv_tile(TID, p.ab_w_in, 2048, (u16*)(p.ws + WS_WIN), 1024, (tt & 15) * 64, (tt >> 4) * 64, 0, tl, p.mix_pre_g);
    } else {
      int tt = t - 2624, i = tt >> 8, t2 = tt & 255;
      tconv_tile(TID, p.mix_w_out + (size_t)i * 1024 * 1024, 1024, (u16*)(p.ws + WS_WOUT) + (size_t)i * 1024 * 1024, 1024,
                 (t2 & 15) * 64, (t2 >> 4) * 64, 0, tl, nullptr);
    }
  }
  const int gtid = blockIdx.x * 512 + TIDX, nth = gridDim.x * 512;
  u16* sgw = (u16*)(p.ws + WS_SGW);
  u16* T1 = (u16*)(p.ws + WS_T1);
  u16* T2 = (u16*)(p.ws + WS_T2);
  u16* T3 = (u16*)(p.ws + WS_T3);
  for (int e = gtid; e < 65536 + 524288 + 65536 + 32768; e += nth) {
    if (e < 65536) {
      sgw[e] = f2bf(p.sg_w[e]);
    } else if (e < 65536 + 524288) {
      int i = e - 65536, grp = i >> 17, n = (i >> 8) & 511, k = i & 255;
      int s = n >> 8, m = n & 255;
      int ph = (m * k) & 255;
      float a = (float)ph * (1.f / 128.f);
      float v = (s == 0 ? cospif(a) : -sinpif(a)) * (1.f / 16.f) * p.mix_pre_g[1024 + grp * 256 + k];
      T1[i] = f2bf(v);
    } else if (e < 65536 + 524288 + 65536) {
      int i = e - 65536 - 524288, n = i >> 8, k = i & 255;
      int sp = n >> 7, k1 = n & 127;
      int s = k >> 7, n1 = k & 127;
      int ph = (k1 * n1) & 127;
      float a = (float)ph * (1.f / 64.f);
      float C = cospif(a), S = sinpif(a);
      float v = (sp == 0) ? (s == 0 ? C : S) : (s == 0 ? -S : C);
      T2[i] = f2bf(v * 0.08838834764831845f);
    } else {
      int i = e - 65536 - 524288 - 65536, k2 = i >> 8, k = i & 255;
      int s = k >> 7, n2 = k & 127;
      int ph = (k2 * n2) & 127;
      float a = (float)ph * (1.f / 64.f);
      float v = (s == 0 ? cospif(a) : sinpif(a)) * 0.08838834764831845f;
      T3[i] = f2bf(v);
    }
  }
}

DEVI void phase_lnv(const int TIDX, const Params& p, u16* ldt) {
  const int SB = TIDX >> 8, TID = TIDX & 255;
  ldt += SB * 32768;
  const u16* proj = (const u16*)(p.ws + WS_BIG);
  u16* vt = (u16*)(p.ws + WS_BIG) + (size_t)T * 2048;
  const int lane = TID & 63, wave = TID >> 6, tid = TID;
  constexpr int LR = 132;
  for (int t = 2 * blockIdx.x + SB; t < 1536; t += 2 * gridDim.x) {
    const int chunk = t >> 2, head = t & 3;
    const float g0 = p.sg_ln_g[head * 128 + lane], g1 = p.sg_ln_g[head * 128 + 64 + lane];
    const float b0 = p.sg_ln_b[head * 128 + lane], b1 = p.sg_ln_b[head * 128 + 64 + lane];
#pragma unroll 1
    for (int pb = 0; pb < 4; ++pb) {
      const int pos0 = wave * 32 + pb * 8;
      const u16* src0 = proj + ((long)chunk * 128 + pos0) * 2048 + 512;
      uint4 sv[8];
      u16 h0[8], h1[8];
#pragma unroll
      for (int i = 0; i < 8; ++i) {
        const u16* src = src0 + (long)i * 2048;
        sv[i] = *(const uint4*)(src + lane * 8);
        h0[i] = src[head * 128 + lane];
        h1[i] = src[head * 128 + 64 + lane];
      }
      float sm[8], sq[8];
#pragma unroll
      for (int i = 0; i < 8; ++i) {
        const float e0 = bf_lo(sv[i].x), e1 = bf_hi(sv[i].x), e2 = bf_lo(sv[i].y), e3 = bf_hi(sv[i].y);
        const float e4 = bf_lo(sv[i].z), e5 = bf_hi(sv[i].z), e6 = bf_lo(sv[i].w), e7 = bf_hi(sv[i].w);
        sm[i] = ((e0 + e1) + (e2 + e3)) + ((e4 + e5) + (e6 + e7));
        sq[i] = ((e0 * e0 + e1 * e1) + (e2 * e2 + e3 * e3)) + ((e4 * e4 + e5 * e5) + (e6 * e6 + e7 * e7));
      }
#pragma unroll
      for (int m = 32; m >= 1; m >>= 1) {
#pragma unroll
        for (int i = 0; i < 8; ++i) {
          sm[i] += shx(sm[i], m, lane);
          sq[i] += shx(sq[i], m, lane);
        }
      }
#pragma unroll
      for (int i = 0; i < 8; ++i) {
        const float mean = sm[i] * (1.f / 512.f);
        const float var = fmaxf(sq[i] * (1.f / 512.f) - mean * mean, 0.f);
        const float r = rsqrtf(var + EPS);
        ldt[lane * LR + pos0 + i] = f2bf((bf2f(h0[i]) - mean) * r * g0 + b0);
        ldt[(lane + 64) * LR + pos0 + i] = f2bf((bf2f(h1[i]) - mean) * r * g1 + b1);
      }
    }
    __syncthreads();
#pragma unroll
    for (int it = 0; it < 8; ++it) {
      int item = it * 256 + tid, pg = item & 15, c = item >> 4;
      const uint2* s2 = (const uint2*)(ldt + c * LR + pg * 8);
      uint2 lo = s2[0], hi = s2[1];
      uint4 o;
      o.x = lo.x; o.y = lo.y; o.z = hi.x; o.w = hi.y;
      *(uint4*)(vt + (((long)head * 384 + chunk) * 128 + c) * 128 + pg * 8) = o;
    }
    __syncthreads();
  }
}

template <int RR>
struct ConvRow {
  static DEVI void run(const u32* lc, int tid, const float (&w)[31][2], float (&o)[32][2]) {
    const u32 cv = lc[RR * 256 + tid];
    const float c0 = bf_lo(cv), c1 = bf_hi(cv);
#pragma unroll
    for (int j = 0; j < 31; ++j) {
      const int tt = RR - j;
      if (tt >= 0 && tt < 32) {
        o[tt][0] += w[j][0] * c0;
        o[tt][1] += w[j][1] * c1;
      }
    }
    ConvRow<RR + 1>::run(lc, tid, w, o);
  }
};
template <>
struct ConvRow<62> {
  static DEVI void run(const u32*, int, const float (&)[31][2], float (&)[32][2]) {}
};

DEVI void phase_conv(const int TIDX, const Params& p, unsigned char* ldsb) {
  const int SB = TIDX >> 8, TID = TIDX & 255;
  ldsb += SB * 65536;
  const u16* proj = (const u16*)(p.ws + WS_BIG);
  u16* cat = (u16*)(p.ws + WS_H);
  u32* lc = (u32*)ldsb;
  float* lf = (float*)ldsb;
  const int lane = TID & 63, wave = TID >> 6, tid = TID;
  float w[31][2];
#pragma unroll
  for (int j = 0; j < 31; ++j) {
    float2 wv = *(const float2*)(p.conv_w + j * 512 + 2 * tid);
    w[j][0] = wv.x;
    w[j][1] = wv.y;
  }
  const float2 cb = *(const float2*)(p.conv_b + 2 * tid);
  float lg[8], lb[8];
#pragma unroll
  for (int j = 0; j < 8; ++j) {
    lg[j] = p.conv_ln_g[lane * 8 + j];
    lb[j] = p.conv_ln_b[lane * 8 + j];
  }
  for (int t = 2 * blockIdx.x + SB; t < 1536; t += 2 * gridDim.x) {
    const int t0 = t * 32;
    int seq_lo, seq_hi;
    if (t0 < TP) { seq_lo = 0; seq_hi = TP; }
    else { seq_lo = TP + ((t0 - TP) >> 11) * 2048; seq_hi = seq_lo + 2048; }
#pragma unroll 1
    for (int r0 = 0; r0 < 64; r0 += 32) {
      u32 av[32], gv[32];
#pragma unroll
      for (int i = 0; i < 32; ++i) {
        const int tok = t0 - 15 + r0 + i;
        av[i] = 0; gv[i] = 0;
        if (r0 + i < 62 && tok >= seq_lo && tok < seq_hi) {
          av[i] = *(const u32*)(proj + (long)tok * 2048 + 1024 + 2 * tid);
          gv[i] = *(const u32*)(proj + (long)tok * 2048 + 1536 + 2 * tid);
        }
      }
#pragma unroll
      for (int i = 0; i < 32; ++i) {
        if (r0 + i < 62)
          lc[(r0 + i) * 256 + tid] = pack2(bf_lo(av[i]) * sigmoidf_(bf_lo(gv[i])), bf_hi(av[i]) * sigmoidf_(bf_hi(gv[i])));
      }
    }
    float o[32][2];
#pragma unroll
    for (int i = 0; i < 32; ++i) { o[i][0] = cb.x; o[i][1] = cb.y; }
    ConvRow<0>::run(lc, tid, w, o);
    __syncthreads();
#pragma unroll
    for (int i = 0; i < 32; ++i) {
      float2 ov; ov.x = o[i][0]; ov.y = o[i][1];
      *(float2*)(lf + i * 512 + 2 * tid) = ov;
    }
    __syncthreads();
#pragma unroll 1
    for (int ib = 0; ib < 2; ++ib) {
      float v[4][8], sm[4], sq[4];
#pragma unroll
      for (int i = 0; i < 4; ++i) {
        const int tl = wave * 8 + ib * 4 + i;
        const float4 v0 = *(const float4*)(lf + tl * 512 + lane * 8);
        const float4 v1 = *(const float4*)(lf + tl * 512 + lane * 8 + 4);
        v[i][0] = v0.x; v[i][1] = v0.y; v[i][2] = v0.z; v[i][3] = v0.w; v[i][4] = v1.x; v[i][5] = v1.y; v[i][6] = v1.z; v[i][7] = v1.w;
        sm[i] = ((v0.x + v0.y) + (v0.z + v0.w)) + ((v1.x + v1.y) + (v1.z + v1.w));
      }
#pragma unroll
      for (int m = 32; m >= 1; m >>= 1)
#pragma unroll
        for (int i = 0; i < 4; ++i) sm[i] += shx(sm[i], m, lane);
#pragma unroll
      for (int i = 0; i < 4; ++i) {
        const float mean = sm[i] * (1.f / 512.f);
        sq[i] = 0.f;
#pragma unroll
        for (int j = 0; j < 8; ++j) { v[i][j] -= mean; sq[i] += v[i][j] * v[i][j]; }
      }
#pragma unroll
      for (int m = 32; m >= 1; m >>= 1)
#pragma unroll
        for (int i = 0; i < 4; ++i) sq[i] += shx(sq[i], m, lane);
#pragma unroll
      for (int i = 0; i < 4; ++i) {
        const int tl = wave * 8 + ib * 4 + i;
        const float r = rsqrtf(sq[i] * (1.f / 512.f) + EPS);
#pragma unroll
        for (int j = 0; j < 8; ++j) v[i][j] = siluf_(v[i][j] * r * lg[j] + lb[j]);
        uint4 ov;
        ov.x = pack2(v[i][0], v[i][1]); ov.y = pack2(v[i][2], v[i][3]); ov.z = pack2(v[i][4], v[i][5]); ov.w = pack2(v[i][6], v[i][7]);
        *(uint4*)(cat + (long)(t0 + tl) * 1024 + 512 + lane * 8) = ov;
      }
    }
    __syncthreads();
  }
}

__global__ void __launch_bounds__(512, 2) fwd_megakernel(Params p) {
  cg::grid_group grid = cg::this_grid();
  extern __shared__ __attribute__((aligned(16))) unsigned char lds_raw[];
  u16* lds = (u16*)lds_raw;
  LAS unsigned char* ldsl = (LAS unsigned char*)lds_raw;
  __shared__ uint4 xb_words;
  if (threadIdx.x == 0) xb_words = make_uint4(0u, 0u, 0u, 0u);
  __syncthreads();
  const int wave_s = __builtin_amdgcn_readfirstlane((int)(threadIdx.x >> 6));
  XcdBarrier xb = xcd_barrier_post((int)threadIdx.x, (unsigned*)(p.ws + WS_BAR), (volatile LAS3 unsigned*)&xb_words);
#ifndef PROBE_DUP
#define PROBE_DUP 0
#endif
#if PROBE_DUP
  static constexpr unsigned char prog[] = {0, 1, 1, 2, 2, 3, 4, 4, 5, 6, 7, 7, 19, 17, 17, 18, 18, 35, 33, 33, 34, 34, 51, 8, 9, 10, 11, 12, 13, 23, 23, 67, 49, 49, 50, 50, 83};
#else
  static constexpr unsigned char prog[] = {0, 1, 2, 3, 4, 5, 6, 7, 19, 17, 18, 35, 33, 34, 51, 8, 9, 10, 23, 67, 49, 50, 83};
#endif
  constexpr int NPH = (int)sizeof(prog);
#pragma unroll 1
  for (int ph = 0; ph < NPH; ++ph) {
    const int op = prog[ph] & 15, arg = prog[ph] >> 4;
    const int reps = (op == 1 || op == 2 || op == 4 || op == 7) ? REP_BIG : ((op == 5 || op == 6 || op >= 8) ? REP_SMALL : 1);
    for (int rep = 0; rep < reps; ++rep) {
      if (rep) { int t2 = threadIdx.x; asm volatile("" : "+v"(t2)); xcd_barrier(t2, xb); }
      int tid = threadIdx.x;
      asm volatile("" : "+v"(tid));
    switch (op) {
        case 0:
          phase_prep(tid, p, (float*)lds_raw);
          phase_norm(tid, p, 0, nullptr, 0.f, nullptr);
          break;
        case 1:
          phase_g1(tid, p, arg, ldsl);
          if (arg < 3) {
            if (gridDim.x == 256) prep_ffn_in_tail(tid, p, arg + 1, (float*)lds_raw);
            else prep_ffn_all(tid, p, arg + 1, (float*)lds_raw);
          }
          break;
        case 2: phase_g2(tid, p, arg, ldsl); break;
        case 3: {
          const bool mix = (arg == 1 || arg == 4);
          const int fidx = (arg == 0) ? 0 : (arg == 2) ? 1 : (arg == 3) ? 2 : 3;
          const float* post = mix ? p.mix_post_g + (arg == 1 ? 0 : 1024) : p.ffn_post_g + fidx * 1024;
          phase_norm(tid, p, arg == 5 ? 2 : (arg == 3 ? 3 : 1), (const u16*)(p.ws + (mix ? WS_BIG : WS_H)), mix ? 1.0f : 0.5f, post);
        } break;
        case 4: phase_gin(tid, p, ldsl); break;
        case 5:
          phase_lnv(tid, p, lds);
          phase_conv(tid, p, lds_raw);
          break;
        case 6: phase_sgu(tid, p, lds); break;
        case 7: phase_gout(tid, p, arg, ldsl); break;
        case 8: {
          unsigned am0 = ~0u; asm volatile("" : "+s"(am0)); int t2 = wave_s * 64 + (int)__builtin_amdgcn_mbcnt_hi(am0, __builtin_amdgcn_mbcnt_lo(am0, 0u)); asm volatile("" : "+v"(t2));
          phase_f1_pg8<false>(t2, p, ldsl);
          unsigned am = ~0u; asm volatile("" : "+s"(am)); int t3 = wave_s * 64 + (int)__builtin_amdgcn_mbcnt_hi(am, __builtin_amdgcn_mbcnt_lo(am, 0u)); asm volatile("" : "+v"(t3));
          phase_f1_pg8<true>(t3, p, ldsl);
        } break;
        case 9: {
          unsigned am0 = ~0u; asm volatile("" : "+s"(am0)); int t2 = wave_s * 64 + (int)__builtin_amdgcn_mbcnt_hi(am0, __builtin_amdgcn_mbcnt_lo(am0, 0u)); asm volatile("" : "+v"(t2));
          phase_fa_pg8<false>(t2, p, ldsl);
          unsigned am = ~0u; asm volatile("" : "+s"(am)); int t3 = wave_s * 64 + (int)__builtin_amdgcn_mbcnt_hi(am, __builtin_amdgcn_mbcnt_lo(am, 0u)); asm volatile("" : "+v"(t3));
          phase_fa_pg8<true>(t3, p, ldsl);
        } break;
        default: {
          unsigned am0 = ~0u; asm volatile("" : "+s"(am0)); int t2 = wave_s * 64 + (int)__builtin_amdgcn_mbcnt_hi(am0, __builtin_amdgcn_mbcnt_lo(am0, 0u)); asm volatile("" : "+v"(t2));
          phase_fb_prompt(t2, p, lds);
          unsigned am = ~0u; asm volatile("" : "+s"(am)); int t3 = wave_s * 64 + (int)__builtin_amdgcn_mbcnt_hi(am, __builtin_amdgcn_mbcnt_lo(am, 0u)); asm volatile("" : "+v"(t3));
          phase_fb_sample(t3, p);
        } break;
      }
    }
    if (ph != NPH - 1) for (int rb = 0; rb < REP_BAR; ++rb) {
      if (p.ws == nullptr) grid_barrier(grid);
      { int t2 = threadIdx.x; asm volatile("" : "+v"(t2)); xcd_barrier(t2, xb); }
    }
  }
}

extern "C" void kernel_launch(void* const* d_in, const int* in_sizes, int n_in, void* d_out, int out_size, void* d_ws,
                              size_t ws_size, hipStream_t stream) {
  static int grid_blocks = 0;
  if (!grid_blocks) {
    int dev = 0, cus = 0, per_cu = 0;
    (void)hipGetDevice(&dev);
    (void)hipDeviceGetAttribute(&cus, hipDeviceAttributeMultiprocessorCount, dev);
    (void)hipFuncSetAttribute((const void*)fwd_megakernel, hipFuncAttributeMaxDynamicSharedMemorySize, 131072);
    (void)hipOccupancyMaxActiveBlocksPerMultiprocessor(&per_cu, fwd_megakernel, 512, 131072);
    if (per_cu > 1) per_cu = 1;
    if (per_cu < 1) per_cu = 1;
    grid_blocks = cus * per_cu;
    if (ws_size < WS_END) {
      fprintf(stderr, "workspace too small: %zu < %zu\n", ws_size, (size_t)WS_END);
      grid_blocks = -1;
    }
  }
  if (grid_blocks < 0) return;
  Params p{};
  p.xp = (const float*)d_in[0]; p.xs = (const float*)d_in[1]; p.ffn_pre_g = (const float*)d_in[2];
  p.w_gate = (const float*)d_in[3]; p.w_up = (const float*)d_in[4]; p.w_down = (const float*)d_in[5];
  p.ffn_post_g = (const float*)d_in[6]; p.mix_pre_g = (const float*)d_in[7]; p.mix_w_out = (const float*)d_in[8];
  p.mix_post_g = (const float*)d_in[9]; p.ab_w_in = (const float*)d_in[10]; p.sg_ln_g = (const float*)d_in[11];
  p.sg_ln_b = (const float*)d_in[12]; p.sg_w = (const float*)d_in[13]; p.sg_b = (const float*)d_in[14];
  p.conv_w = (const float*)d_in[15]; p.conv_b = (const float*)d_in[16]; p.conv_ln_g = (const float*)d_in[17];
  p.conv_ln_b = (const float*)d_in[18];
  p.out = (float*)d_out;
  p.ws = (unsigned char*)d_ws;
  (void)hipMemsetAsync((unsigned char*)d_ws + WS_BAR, 0, 16384, stream);
  void* args[] = {&p};
  hipError_t e = hipLaunchCooperativeKernel((void*)fwd_megakernel, dim3(grid_blocks), dim3(512), args, 131072, stream);
  if (e != hipSuccess) fprintf(stderr, "cooperative launch failed: %s (grid %d)\n", hipGetErrorString(e), grid_blocks);
}
```

```cpp
#include <hip/hip_runtime.h>
#include <hip/hip_bf16.h>
#include <hip/hip_cooperative_groups.h>
#include <cstdio>
namespace cg = cooperative_groups;

typedef unsigned short u16;
typedef unsigned int u32;
typedef __attribute__((ext_vector_type(8))) short bf16x8;
typedef __attribute__((ext_vector_type(16))) float f32x16;
typedef __attribute__((ext_vector_type(4))) float f32x4;
#define DEVI __device__ __forceinline__

#ifndef REP_BIG
#define REP_BIG 1
#endif
#ifndef REP_SMALL
#define REP_SMALL 1
#endif
#ifndef REP_BAR
#define REP_BAR 1
#endif
constexpr int T = 49152;
constexpr int TP = 16384;
constexpr int D = 1024;
constexpr int FF = 2816;
constexpr float EPS = 1e-6f;

constexpr size_t WS_WGU = 0;
constexpr size_t WS_WD = WS_WGU + (size_t)2 * 5632 * 1024 * 2;
constexpr size_t WS_WIN = WS_WD + (size_t)2 * 1024 * 2816 * 2;
constexpr size_t WS_WOUT = WS_WIN + (size_t)2048 * 1024 * 2;
constexpr size_t WS_SGW = WS_WOUT + (size_t)2 * 1024 * 1024 * 2;
constexpr size_t WS_T1 = WS_SGW + (size_t)4 * 128 * 128 * 2;
constexpr size_t WS_T2 = WS_T1 + (size_t)4 * 512 * 256 * 2;
constexpr size_t WS_T3 = WS_T2 + (size_t)256 * 256 * 2;
constexpr size_t WS_STAT = WS_T3 + (size_t)128 * 256 * 2;
constexpr size_t WS_H = WS_STAT + (size_t)T * 4;
constexpr size_t WS_XB = WS_H + (size_t)T * 1024 * 2;
constexpr size_t WS_BIG = WS_XB + (size_t)T * 1024 * 2;
constexpr size_t WS_BAR = WS_BIG + (size_t)T * 2816 * 2;
constexpr size_t WS_END = WS_BAR + 16384;

struct Params {
  const float *xp, *xs, *ffn_pre_g, *w_gate, *w_up, *w_down, *ffn_post_g, *mix_pre_g, *mix_w_out, *mix_post_g,
      *ab_w_in, *sg_ln_g, *sg_ln_b, *sg_w, *sg_b, *conv_w, *conv_b, *conv_ln_g, *conv_ln_b;
  float* out;
  unsigned char* ws;
};

typedef __bf16 bf2v __attribute__((ext_vector_type(2)));
typedef float f2v __attribute__((ext_vector_type(2)));
DEVI u32 pack2(float lo, float hi) {
  f2v v = {lo, hi};
  bf2v r = __builtin_convertvector(v, bf2v);
  return __builtin_bit_cast(u32, r);
}
DEVI void grid_barrier(cg::grid_group& grid) {
  asm volatile("s_waitcnt vmcnt(0) lgkmcnt(0)" ::: "memory");
  grid.sync();
  __builtin_amdgcn_fence(__ATOMIC_ACQUIRE, "agent");
  asm volatile("s_waitcnt vmcnt(0)" ::: "memory");
}
DEVI u16 f2bf(float f) { return (u16)(pack2(f, 0.f) & 0xffffu); }
DEVI float bf_lo(u32 v) { return __uint_as_float(v << 16); }
DEVI float bf_hi(u32 v) { return __uint_as_float(v & 0xffff0000u); }
DEVI float bf2f(u16 h) { return __uint_as_float(((u32)h) << 16); }
DEVI float shx(float v, int m, int lane) {
  return __int_as_float(__builtin_amdgcn_ds_bpermute(((lane ^ m) & 63) << 2, __float_as_int(v)));
}
DEVI float wave_sum(float v, int lane) {
#pragma unroll
  for (int m = 32; m >= 1; m >>= 1) v += shx(v, m, lane);
  return v;
}
DEVI float sigmoidf_(float x) { return __builtin_amdgcn_rcpf(1.f + __builtin_amdgcn_exp2f(-1.4426950408889634f * x)); }
DEVI float siluf_(float x) { return x * sigmoidf_(x); }
DEVI float geluf_(float x) {
  const float u2 = 1.5957691216057308f * (x + 0.044715f * x * x * x);
  return x * sigmoidf_(u2);
}


#define XB_TMO      128
#define XB_XCNT(j)  (256  + 64 * (j))
#define XB_XSUB(j)  (1280 + 64 * (j))
#define XB_XGEN(j)  (2304 + 64 * (j))
#define XB_TOP      3328
#define XB_TOPGEN   3392
#define XCD_BAR_WORDS 3456
#define XB_SPIN_CAP (1u << 20)
#define LAS3 __attribute__((address_space(3)))
DEVI unsigned xb_ld(unsigned* p) { return __hip_atomic_load(p, __ATOMIC_RELAXED, __HIP_MEMORY_SCOPE_AGENT); }
DEVI unsigned xb_add(unsigned* p, unsigned v) { return __hip_atomic_fetch_add(p, v, __ATOMIC_RELAXED, __HIP_MEMORY_SCOPE_AGENT); }
DEVI unsigned xb_xcc_id() { return (unsigned)__builtin_amdgcn_s_getreg((3 << 11) | 20) & 0xFu; }
#define XB_SPIN(cond, bar) do { unsigned _sp = 0; while (cond) { __builtin_amdgcn_s_sleep(1); \
    if ((++_sp & 255u) == 0u) { if (xb_ld(&(bar)[XB_TMO])) break; if (_sp > XB_SPIN_CAP) { atomicAdd(&(bar)[XB_TMO], 1u); break; } } } } while (0)
struct XcdBarrier { unsigned* bar; unsigned x; volatile LAS3 unsigned* st; };
DEVI XcdBarrier xcd_barrier_post(const int TIDX, unsigned* bar, volatile LAS3 unsigned* st) {
  XcdBarrier b; b.bar = bar; b.x = xb_xcc_id(); b.st = st;
  if (TIDX == 0) (void)xb_add(&bar[XB_XCNT(b.x)], 1u);
  return b;
}
DEVI void xcd_barrier_complete(unsigned* bar, unsigned x, unsigned& nloc, unsigned& nx) {
  const unsigned G = gridDim.x * gridDim.y * gridDim.z;
  unsigned sum, cnt, mine, sp = 0u;
  for (;;) {
    sum = 0u; cnt = 0u; mine = 0u;
#pragma unroll
    for (unsigned j = 0; j < 16; ++j) { const unsigned c = xb_ld(&bar[XB_XCNT(j)]); sum += c; cnt += (c > 0u) ? 1u : 0u; mine = (j == x) ? c : mine; }
    if (sum == G) break;
    __builtin_amdgcn_s_sleep(1);
    if ((++sp & 255u) == 0u) { if (xb_ld(&bar[XB_TMO])) break; if (sp > XB_SPIN_CAP) { atomicAdd(&bar[XB_TMO], 1u); break; } }
  }
  nloc = mine > 0u ? mine : 1u; nx = cnt > 0u ? cnt : 1u;
}
DEVI void xcd_barrier(const int TIDX, const XcdBarrier& b) {
  asm volatile("s_waitcnt vmcnt(0) lgkmcnt(0)" ::: "memory");
  __syncthreads();
  if (TIDX == 0) {
    unsigned* bar = b.bar;
    __builtin_amdgcn_s_waitcnt(0);
    unsigned nloc = b.st[0], nx = b.st[1];
    if (nloc == 0u) { xcd_barrier_complete(bar, b.x, nloc, nx); b.st[0] = nloc; b.st[1] = nx; }
    const unsigned old = xb_add(&bar[XB_XSUB(b.x)], 1u);
    const unsigned gen = old / nloc;
    if (old + 1u == (gen + 1u) * nloc) {
      __builtin_amdgcn_fence(__ATOMIC_RELEASE, "agent");
      asm volatile("s_waitcnt vmcnt(0)" ::: "memory");
      const unsigned og = xb_add(&bar[XB_TOP], 1u);
      const unsigned tg = og / nx;
      if (og + 1u == (tg + 1u) * nx) xb_add(&bar[XB_TOPGEN], 1u);
      else XB_SPIN(xb_ld(&bar[XB_TOPGEN]) == tg, bar);
      __builtin_amdgcn_fence(__ATOMIC_ACQUIRE, "agent");
      xb_add(&bar[XB_XGEN(b.x)], 1u);
      asm volatile("s_waitcnt vmcnt(0)" ::: "memory");
    } else {
      XB_SPIN(xb_ld(&bar[XB_XGEN(b.x)]) == gen, bar);
      __builtin_amdgcn_fence(__ATOMIC_ACQUIRE, "agent");
      asm volatile("s_waitcnt vmcnt(0)" ::: "memory");
    }
  }
  __syncthreads();
}

constexpr int BM = 256, BN = 128, BK = 32;
constexpr int LROW = 40;
constexpr int A_BUF = BM * LROW;
constexpr int STAGE = (BM + BN) * LROW;

DEVI void tile_map(int t, int NT, int& mt, int& nt) {
  int xcd = t & 7, s = t >> 3;
  int per = 8 * NT;
  int mgl = s / per, rem = s - mgl * per;
  nt = rem >> 3;
  mt = ((mgl * 8 + xcd) << 3) + (rem & 7);
}

template <class AOff>
DEVI void gemm_mainloop(const int TIDX, const u16* __restrict__ A, AOff aoff, const u16* __restrict__ B, long ldb, int K, u16* lds,
                        f32x16 (&acc)[4][2]) {
  const int tid = TIDX, lane = tid & 63, wave = tid >> 6;
  const int wm = wave >> 1, wn = wave & 1;
  const int c4 = tid & 3, r0 = tid >> 2;
  const u16* ap[4];
  const u16* bp[2];
#pragma unroll
  for (int i = 0; i < 4; ++i) ap[i] = A + aoff(r0 + 64 * i) + c4 * 8;
#pragma unroll
  for (int i = 0; i < 2; ++i) bp[i] = B + (long)(r0 + 64 * i) * ldb + c4 * 8;
#pragma unroll
  for (int mb = 0; mb < 4; ++mb)
#pragma unroll
    for (int nb = 0; nb < 2; ++nb)
#pragma unroll
      for (int j = 0; j < 16; ++j) acc[mb][nb][j] = 0.f;

  uint4 ra[4], rb[2];
  const int nk = K / BK;
#pragma unroll
  for (int i = 0; i < 4; ++i) ra[i] = *(const uint4*)(ap[i]);
#pragma unroll
  for (int i = 0; i < 2; ++i) rb[i] = *(const uint4*)(bp[i]);
  {
    u16* st = lds;
#pragma unroll
    for (int i = 0; i < 4; ++i) *(uint4*)(st + (r0 + 64 * i) * LROW + c4 * 8) = ra[i];
#pragma unroll
    for (int i = 0; i < 2; ++i) *(uint4*)(st + A_BUF + (r0 + 64 * i) * LROW + c4 * 8) = rb[i];
  }
  __syncthreads();
  for (int kt = 0; kt < nk; ++kt) {
    const bool more = (kt + 1 < nk);
    if (more) {
#pragma unroll
      for (int i = 0; i < 4; ++i) ra[i] = *(const uint4*)(ap[i] + (kt + 1) * BK);
#pragma unroll
      for (int i = 0; i < 2; ++i) rb[i] = *(const uint4*)(bp[i] + (kt + 1) * BK);
    }
    const u16* st = lds + (kt & 1) * STAGE;
    const u16* sa = st + (wm * 128 + (lane & 31)) * LROW + (lane >> 5) * 8;
    const u16* sb = st + A_BUF + (wn * 64 + (lane & 31)) * LROW + (lane >> 5) * 8;
#pragma unroll
    for (int ks = 0; ks < 2; ++ks) {
      bf16x8 af[4], bfr[2];
#pragma unroll
      for (int mb = 0; mb < 4; ++mb) af[mb] = *(const bf16x8*)(sa + mb * 32 * LROW + ks * 16);
#pragma unroll
      for (int nb = 0; nb < 2; ++nb) bfr[nb] = *(const bf16x8*)(sb + nb * 32 * LROW + ks * 16);
#pragma unroll
      for (int mb = 0; mb < 4; ++mb)
#pragma unroll
        for (int nb = 0; nb < 2; ++nb)
          acc[mb][nb] = __builtin_amdgcn_mfma_f32_32x32x16_bf16(af[mb], bfr[nb], acc[mb][nb], 0, 0, 0);
    }
    if (more) {
      u16* sw = lds + ((kt + 1) & 1) * STAGE;
#pragma unroll
      for (int i = 0; i < 4; ++i) *(uint4*)(sw + (r0 + 64 * i) * LROW + c4 * 8) = ra[i];
#pragma unroll
      for (int i = 0; i < 2; ++i) *(uint4*)(sw + A_BUF + (r0 + 64 * i) * LROW + c4 * 8) = rb[i];
    }
    __syncthreads();
  }
}


DEVI void epi_store_rm(const int TIDX, f32x16 (&acc)[4][2], u16* dst, long ld, long row0, int col0, bool GELU) {
  const int lane = TIDX & 63, wave = TIDX >> 6, wm = wave >> 1, wn = wave & 1;
#pragma unroll
  for (int mb = 0; mb < 4; ++mb)
#pragma unroll
    for (int nb = 0; nb < 2; ++nb)
#pragma unroll
      for (int rg = 0; rg < 4; ++rg)
#pragma unroll
        for (int i = 0; i < 4; ++i) {
          long row = row0 + wm * 128 + mb * 32 + rg * 8 + (lane >> 5) * 4 + i;
          int col = col0 + wn * 64 + nb * 32 + (lane & 31);
          float v = acc[mb][nb][rg * 4 + i];
          if (GELU) v = geluf_(v);
          dst[row * ld + col] = f2bf(v);
        }
}


#define LAS __attribute__((address_space(3)))
typedef unsigned u32x4 __attribute__((ext_vector_type(4)));
namespace pg8 {
constexpr int BM = 256, BK = 64, HALF = 128, HTB = HALF * BK * 2, STAGE_BYTES = 8 * HTB, NXCD = 8, WGM = 4;
DEVI int lds_byte(int r, int c) { const int st = (r >> 4) * 2 + (c >> 5), rr = r & 15, cc = c & 31, ob = rr * 64 + cc * 2; return st * 1024 + (ob ^ (((ob >> 9) & 1) << 5)); }
DEVI void stage_rc(int b, int& R, int& C) { const int st = b / 1024, sb = b % 1024, swz = sb ^ (((sb >> 9) & 1) << 5); R = (st >> 1) * 16 + swz / 64; C = (st & 1) * 32 + (swz % 64) / 2; }
DEVI int perm32(int rho) { const int n = rho >> 4, i = rho & 15; return 8 * (i >> 2) + 4 * n + (i & 3); }
struct Unit { int pm, pn; };
struct Gemm { const u16* A; const u16* Bt; int M, N, K; };
struct StaticOrder {
  int nM, nN, nwg, G, c;
  DEVI void init(int M, int N, int G_, int c_) { nM = M / BM; nN = N / BM; nwg = nM * nN; G = G_; c = c_; }
  DEVI bool next(int i, Unit& u) const {
    const long L = (long)i * G + c; if (L >= nwg) return false;
    int wgid = (int)L; { const int q = nwg / NXCD, r = nwg % NXCD, xcd = wgid % NXCD, off = wgid / NXCD; wgid = (xcd < r ? xcd * (q + 1) : r * (q + 1) + (xcd - r) * q) + off; }
    const int nig = WGM * nN, gid = wgid / nig, fm = gid * WGM, gsz = (nM - fm) < WGM ? (nM - fm) : WGM;
    u.pm = fm + ((wgid % nig) % gsz); u.pn = (wgid % nig) / gsz; return true;
  }
};
struct AddrPlain {
  const char *A, *B; unsigned rowA, rowB; size_t hA, hB;
  DEVI AddrPlain(const u16* A_, const u16* B_, int K) : A((const char*)A_), B((const char*)B_), rowA(K * 2), rowB(K * 2), hA((size_t)HALF * K * 2), hB((size_t)HALF * K * 2) {}
  DEVI const char* a(const Unit& u) const { return A + (size_t)u.pm * 2 * hA; }
  DEVI const char* b(const Unit& u) const { return B + (size_t)u.pn * 2 * hB; }
};
template <class Epi, class Addr>
DEVI void gemm_phase_ad(const int TIDX, LAS unsigned char* lds, const Gemm g, const Addr& ad, const Epi& E) {
  const int tid = TIDX, wid = __builtin_amdgcn_readfirstlane(tid >> 6), lane = tid & 63, wr = wid >> 2, wc = wid & 3, fr = lane & 15, fq = lane >> 4;
  const int K = g.K, nt = K / BK;
  StaticOrder S; S.init(g.M, g.N, (int)gridDim.x, (int)blockIdx.x);
  unsigned voffA[2], voffB[2];
#pragma unroll
  for (int i = 0; i < 2; ++i) { int R, C; stage_rc(tid * 16 + i * 8192, R, C); const int Rb = Epi::PERM ? ((R & ~31) + perm32(R & 31)) : R;
    voffA[i] = (unsigned)R * ad.rowA + (unsigned)C * 2u; voffB[i] = (unsigned)Rb * ad.rowB + (unsigned)C * 2u; }
  const size_t kstep = (size_t)(BK * 2);
  const size_t hstepA = ad.hA, hstepB = ad.hB;
  const unsigned ldsw = (unsigned)wid * 1024u;
  const int aoff = lds_byte(wr * 64 + fr, fq * 8), boff = lds_byte(wc * 32 + fr, fq * 8);
#define PG8_SA(b, h) (((b) * 2 + (h)) * HTB)
#define PG8_SB(b, h) ((4 + (b) * 2 + (h)) * HTB)
#define PG8_STAGE(bufoff, gbase, voff) do { _Pragma("unroll") for (int _i = 0; _i < 2; ++_i) \
    __builtin_amdgcn_global_load_lds((const unsigned*)((const char*)(gbase) + (voff)[_i]), (LAS unsigned*)(lds + (bufoff) + ldsw + _i * 8192), 16, 0, 0); } while (0)
#define PG8_LDA(dst, b, h) do { _Pragma("unroll") for (int m = 0; m < 4; ++m) _Pragma("unroll") for (int k = 0; k < 2; ++k) dst[m][k] = *(const LAS bf16x8*)(lds + PG8_SA(b, h) + aoff + m * 2048 + k * 1024); } while (0)
#define PG8_LDB(dst, b, h) do { _Pragma("unroll") for (int n = 0; n < 2; ++n) _Pragma("unroll") for (int k = 0; k < 2; ++k) dst[n][k] = *(const LAS bf16x8*)(lds + PG8_SB(b, h) + boff + n * 2048 + k * 1024); } while (0)
#define PG8_MMA(ai, bj, At, Bt) do { __builtin_amdgcn_s_setprio(1); _Pragma("unroll") for (int m = 0; m < 4; ++m) _Pragma("unroll") for (int n = 0; n < 2; ++n) _Pragma("unroll") for (int k = 0; k < 2; ++k) \
    acc[ai][bj][m][n] = __builtin_amdgcn_mfma_f32_16x16x32_bf16(Bt[n][k], At[m][k], acc[ai][bj][m][n], 0, 0, 0); __builtin_amdgcn_s_setprio(0); } while (0)
#define PG8_WAIT_V(n) asm volatile("s_waitcnt vmcnt(" #n ")" ::: "memory")
#define PG8_WAIT_L(n) asm volatile("s_waitcnt lgkmcnt(" #n ")" ::: "memory")
#define PG8_BAR __builtin_amdgcn_s_barrier()
#define PG8_SCHED __builtin_amdgcn_sched_barrier(0)
  Unit cur, nxt; int ui = 0;
  if (!S.next(0, cur)) return;
  f32x4 acc[2][2][4][2];
#pragma unroll
  for (int a = 0; a < 2; ++a)
#pragma unroll
    for (int b = 0; b < 2; ++b)
#pragma unroll
      for (int m = 0; m < 4; ++m)
#pragma unroll
        for (int n = 0; n < 2; ++n) acc[a][b][m][n] = (f32x4){0.f, 0.f, 0.f, 0.f};
  bf16x8 At[4][2], B0[2][2], B1[2][2];
  const char* cA = ad.a(cur); const char* cB = ad.b(cur);
  PG8_STAGE(PG8_SB(0, 0), cB, voffB); PG8_STAGE(PG8_SA(0, 0), cA, voffA); PG8_STAGE(PG8_SB(0, 1), cB + hstepB, voffB); PG8_STAGE(PG8_SA(0, 1), cA + hstepA, voffA);
  if (wr == 1) PG8_BAR;
  PG8_WAIT_V(4); PG8_BAR;
  PG8_STAGE(PG8_SB(1, 0), cB + kstep, voffB); PG8_STAGE(PG8_SA(1, 0), cA + kstep, voffA); PG8_STAGE(PG8_SB(1, 1), cB + hstepB + kstep, voffB);
  PG8_WAIT_V(6); PG8_BAR;
  for (;;) {
    const bool has_next = S.next(ui + 1, nxt);
    const char* nA = has_next ? ad.a(nxt) : cA; const char* nB = has_next ? ad.b(nxt) : cB;
    const typename Epi::Pre pre = E.prefetch(cur, wr, fr);
    for (int t = 0; t < nt; t += 2) {
      const bool last = (t == nt - 2);
      const char* a1 = cA + (size_t)(t + 1) * kstep;
      const char* a2 = last ? nA : cA + (size_t)(t + 2) * kstep; const char* b2 = last ? nB : cB + (size_t)(t + 2) * kstep;
      const char* a3 = a2 + kstep; const char* b3 = b2 + kstep;
      PG8_LDB(B0, 0, 0); PG8_SCHED; PG8_LDA(At, 0, 0); PG8_STAGE(PG8_SA(1, 1), a1 + hstepA, voffA);
      PG8_WAIT_L(8); PG8_BAR; PG8_WAIT_L(0); PG8_MMA(0, 0, At, B0); PG8_BAR; PG8_SCHED;
      PG8_LDB(B1, 0, 1); PG8_STAGE(PG8_SB(0, 0), b2, voffB);
      PG8_BAR; PG8_WAIT_L(0); PG8_MMA(0, 1, At, B1); PG8_BAR;
      PG8_LDA(At, 0, 1); PG8_STAGE(PG8_SA(0, 0), a2, voffA);
      PG8_BAR; PG8_WAIT_L(0); PG8_MMA(1, 0, At, B0); PG8_BAR; PG8_SCHED;
      PG8_STAGE(PG8_SB(0, 1), b2 + hstepB, voffB);
      PG8_WAIT_V(6); PG8_BAR; PG8_MMA(1, 1, At, B1); PG8_BAR;
      PG8_LDB(B0, 1, 0); PG8_SCHED; PG8_LDA(At, 1, 0); PG8_STAGE(PG8_SA(0, 1), a2 + hstepA, voffA);
      PG8_WAIT_L(8); PG8_BAR; PG8_WAIT_L(0); PG8_MMA(0, 0, At, B0); PG8_BAR; PG8_SCHED;
      PG8_LDB(B1, 1, 1); PG8_STAGE(PG8_SB(1, 0), b3, voffB);
      PG8_BAR; PG8_WAIT_L(0); PG8_MMA(0, 1, At, B1); PG8_BAR;
      PG8_LDA(At, 1, 1); PG8_STAGE(PG8_SA(1, 0), a3, voffA);
      PG8_BAR; PG8_WAIT_L(0); PG8_MMA(1, 0, At, B0); PG8_BAR; PG8_SCHED;
      PG8_STAGE(PG8_SB(1, 1), b3 + hstepB, voffB);
      PG8_WAIT_V(6); PG8_BAR; PG8_MMA(1, 1, At, B1); PG8_BAR;
    }
    E(acc, cur, wr, wc, fr, fq, pre);
    if (!has_next) break;
#pragma unroll
    for (int a = 0; a < 2; ++a)
#pragma unroll
      for (int b = 0; b < 2; ++b)
#pragma unroll
        for (int m = 0; m < 4; ++m)
#pragma unroll
          for (int n = 0; n < 2; ++n) acc[a][b][m][n] = (f32x4){0.f, 0.f, 0.f, 0.f};
    cur = nxt; cA = nA; cB = nB; ++ui;
  }
  PG8_WAIT_V(0);
  if (wr == 0) PG8_BAR;
  PG8_BAR;
#undef PG8_SA
#undef PG8_SB
#undef PG8_STAGE
#undef PG8_LDA
#undef PG8_LDB
#undef PG8_MMA
#undef PG8_WAIT_V
#undef PG8_WAIT_L
#undef PG8_BAR
#undef PG8_SCHED
}
template <class Epi>
DEVI void gemm_phase(const int TIDX, LAS unsigned char* lds, const Gemm g, const Epi& E) {
  AddrPlain ad(g.A, g.Bt, g.K);
  gemm_phase_ad(TIDX, lds, g, ad, E);
}
struct PreNone {};
struct PreRows { float s[2][4]; };
struct EpiSwiglu {
  static constexpr bool PERM = true;
  u16* act; const float* stat;
  typedef PreRows Pre;
  DEVI Pre prefetch(const Unit& u, int wr, int fr) const {
    Pre q;
#pragma unroll
    for (int ai = 0; ai < 2; ++ai)
#pragma unroll
      for (int m = 0; m < 4; ++m) q.s[ai][m] = stat[u.pm * BM + wr * 64 + fr + ai * HALF + m * 16];
    return q;
  }
  DEVI void operator()(const f32x4 (&acc)[2][2][4][2], const Unit& u, int wr, int wc, int fr, int fq, const Pre& pre) const {
    const int row0 = u.pm * BM + wr * 64 + fr, col0 = u.pn * 128 + wc * 32 + 8 * fq;
#pragma unroll
    for (int ai = 0; ai < 2; ++ai)
#pragma unroll
      for (int m = 0; m < 4; ++m) {
        const int row = row0 + ai * HALF + m * 16;
        const float r = rsqrtf(pre.s[ai][m] * (1.f / 1024.f) + EPS);
        const float rn = -1.4426950408889634f * r, rr = r * r;
        f32x4 o0, o1;
#pragma unroll
        for (int j = 0; j < 4; ++j) {
          const float g0 = acc[ai][0][m][0][j], g1 = acc[ai][0][m][1][j];
          o0[j] = (g0 * acc[ai][1][m][0][j]) * (rr * __builtin_amdgcn_rcpf(1.f + __builtin_amdgcn_exp2f(g0 * rn)));
          o1[j] = (g1 * acc[ai][1][m][1][j]) * (rr * __builtin_amdgcn_rcpf(1.f + __builtin_amdgcn_exp2f(g1 * rn)));
        }
        u32x4 w; w.x = pack2(o0[0], o0[1]); w.y = pack2(o0[2], o0[3]); w.z = pack2(o1[0], o1[1]); w.w = pack2(o1[2], o1[3]);
        __builtin_nontemporal_store(w, (u32x4*)(act + (size_t)row * FF + col0));
      }
  }
};
struct EpiStore {
  static constexpr bool PERM = true;
  u16* O; int ldc; int gelu_pn; const float* stat;
  typedef PreRows Pre;
  DEVI Pre prefetch(const Unit& u, int wr, int fr) const {
    Pre q;
#pragma unroll
    for (int ai = 0; ai < 2; ++ai)
#pragma unroll
      for (int m = 0; m < 4; ++m) q.s[ai][m] = stat ? stat[u.pm * BM + wr * 64 + fr + ai * HALF + m * 16] : 0.f;
    return q;
  }
  DEVI void operator()(const f32x4 (&acc)[2][2][4][2], const Unit& u, int wr, int wc, int fr, int fq, const Pre& pre) const {
    const int row0 = u.pm * BM + wr * 64 + fr, col0 = u.pn * BM + wc * 32 + 8 * fq;
    const bool ge = u.pn < gelu_pn;
#pragma unroll
    for (int ai = 0; ai < 2; ++ai)
#pragma unroll
      for (int m = 0; m < 4; ++m) {
        const int row = row0 + ai * HALF + m * 16;
        const float r = stat ? rsqrtf(pre.s[ai][m] * (1.f / 1024.f) + EPS) : 1.f;
        u16* rowp = O + (size_t)row * ldc + col0;
#pragma unroll
        for (int bj = 0; bj < 2; ++bj) {
          f32x4 v0 = acc[ai][bj][m][0] * r, v1 = acc[ai][bj][m][1] * r;
          if (ge) {
#pragma unroll
            for (int j = 0; j < 4; ++j) { v0[j] = geluf_(v0[j]); v1[j] = geluf_(v1[j]); }
          }
          u32x4 w; w.x = pack2(v0[0], v0[1]); w.y = pack2(v0[2], v0[3]); w.z = pack2(v1[0], v1[1]); w.w = pack2(v1[2], v1[3]);
          *(u32x4*)(rowp + bj * HALF) = w;
        }
      }
  }
};
template <bool SAMPLE>
struct AddrF1 {
  const char *A, *H; unsigned rowA, rowB; size_t hA, hB;
  DEVI AddrF1(const u16* T1, const u16* H_) : A((const char*)T1), H((const char*)H_), rowA(512), rowB((SAMPLE ? 16 : 128) * 2048), hA((size_t)128 * 512), hB(2048) {}
  DEVI const char* a(const Unit& u) const { const int g = SAMPLE ? (u.pn >> 7) : (u.pn >> 6); return A + (size_t)g * 512 * 512 + (size_t)u.pm * 256 * 512; }
  DEVI const char* b(const Unit& u) const {
    if (SAMPLE) { const int g = u.pn >> 7, bb = (u.pn >> 3) & 15, pair = u.pn & 7; return H + ((size_t)(TP + bb * 2048 + 2 * pair) * 1024 + g * 256) * 2; }
    const int g = u.pn >> 6, pair = u.pn & 63; return H + ((size_t)(2 * pair) * 1024 + g * 256) * 2;
  }
};
template <bool SAMPLE>
struct EpiF1 {
  static constexpr bool PERM = false;
  u16* Zt;
  typedef PreNone Pre;
  DEVI Pre prefetch(const Unit&, int, int) const { return Pre{}; }
  DEVI void operator()(const f32x4 (&acc)[2][2][4][2], const Unit& u, int wr, int wc, int fr, int fq, const Pre&) const {
    const int s = u.pm;
    const int g = SAMPLE ? (u.pn >> 7) : (u.pn >> 6);
    const int bb = (u.pn >> 3) & 15;
    const int pair = SAMPLE ? (u.pn & 7) : (u.pn & 63);
#pragma unroll
    for (int ai = 0; ai < 2; ++ai)
#pragma unroll
      for (int m = 0; m < 4; ++m) {
        const int cp = g * 256 + 128 * ai + 64 * wr + 16 * m + fr;
#pragma unroll
        for (int bj = 0; bj < 2; ++bj) {
          const int n2 = 2 * pair + bj;
          const long rowz = SAMPLE ? (((long)cp * 16 + bb) * 16 + n2) : ((long)cp * 128 + n2);
          u16* dst = Zt + (rowz * 2 + s) * 128 + 32 * wc + 4 * fq;
#pragma unroll
          for (int n = 0; n < 2; ++n) {
            const f32x4 v = acc[ai][bj][m][n];
            uint2 o; o.x = pack2(v[0], v[1]); o.y = pack2(v[2], v[3]);
            *(uint2*)(dst + 16 * n) = o;
          }
        }
      }
  }
};
template <bool SAMPLE>
struct EpiFA {
  static constexpr bool PERM = false;
  u16* Yt;
  typedef PreNone Pre;
  DEVI Pre prefetch(const Unit&, int, int) const { return Pre{}; }
  DEVI void operator()(const f32x4 (&acc)[2][2][4][2], const Unit& u, int wr, int wc, int fr, int fq, const Pre&) const {
    constexpr float W = SAMPLE ? (6.283185307179586f / 2048.f) : (6.283185307179586f / 16384.f);
#pragma unroll
    for (int m = 0; m < 4; ++m) {
      int k1 = 64 * wr + 16 * m + fr;
      asm volatile("" : "+v"(k1));
#pragma unroll
      for (int n = 0; n < 2; ++n) {
        const int n2 = SAMPLE ? 4 * fq : (32 * wc + 16 * n + 4 * fq);
        float ct[4], st[4];
#pragma unroll
        for (int j = 0; j < 4; ++j) {
          const float ang = (float)((n2 + j) * k1) * W;
          ct[j] = __cosf(ang);
          st[j] = __sinf(ang);
        }
#pragma unroll
        for (int bj = 0; bj < 2; ++bj) {
          unsigned off;
          if (SAMPLE) off = ((unsigned)((8 * bj + 2 * wc + n) * 128 + k1) * 1024u + (unsigned)u.pn) * 32u + (unsigned)n2;
          else off = (unsigned)k1 * 262144u + (unsigned)(2 * u.pn + bj) * 256u + (unsigned)n2;
          const f32x4 re = acc[0][bj][m][n], im = acc[1][bj][m][n];
          uint2 o;
          o.x = pack2(re[0] * ct[0] + im[0] * st[0], re[1] * ct[1] + im[1] * st[1]);
          o.y = pack2(re[2] * ct[2] + im[2] * st[2], re[3] * ct[3] + im[3] * st[3]);
          *(uint2*)(Yt + off) = o;
          o.x = pack2(im[0] * ct[0] - re[0] * st[0], im[1] * ct[1] - re[1] * st[1]);
          o.y = pack2(im[2] * ct[2] - re[2] * st[2], im[3] * ct[3] - re[3] * st[3]);
          *(uint2*)(Yt + off + (SAMPLE ? 16 : 128)) = o;
        }
        __builtin_amdgcn_sched_barrier(0);
      }
    }
  }
};
}

template <bool SAMPLE>
DEVI void phase_f1_pg8(const int TIDX, const Params& p, LAS unsigned char* ldsl) {
  pg8::Gemm g{nullptr, nullptr, 512, SAMPLE ? 131072 : 65536, 256};
  pg8::AddrF1<SAMPLE> ad((const u16*)(p.ws + WS_T1), (const u16*)(p.ws + WS_H));
  pg8::EpiF1<SAMPLE> E{(u16*)(p.ws + WS_BIG) + (SAMPLE ? (size_t)131072 * 256 : 0)};
  pg8::gemm_phase_ad(TIDX, ldsl, g, ad, E);
}
template <bool SAMPLE>
DEVI void phase_fa_pg8(const int TIDX, const Params& p, LAS unsigned char* ldsl) {
  pg8::Gemm g{(const u16*)(p.ws + WS_T2), (const u16*)(p.ws + WS_BIG) + (SAMPLE ? (size_t)131072 * 256 : 0), 256, SAMPLE ? 262144 : 131072, 256};
  pg8::EpiFA<SAMPLE> E{(u16*)p.out + (SAMPLE ? (size_t)131072 * 256 : 0)};
  pg8::gemm_phase(TIDX, ldsl, g, E);
}


DEVI void phase_g1(const int TIDX, const Params& p, int f, LAS unsigned char* ldsl) {
  pg8::Gemm g{(const u16*)(p.ws + WS_XB), (const u16*)(p.ws + WS_WGU) + (size_t)(f & 1) * 5632 * 1024, T, 5632, 1024};
  pg8::EpiSwiglu E{(u16*)(p.ws + WS_BIG), (const float*)(p.ws + WS_STAT)};
  pg8::gemm_phase(TIDX, ldsl, g, E);
}
DEVI void phase_g2(const int TIDX, const Params& p, int f, LAS unsigned char* ldsl) {
  pg8::Gemm g{(const u16*)(p.ws + WS_BIG), (const u16*)(p.ws + WS_WD) + (size_t)(f & 1) * 1024 * 2816, T, 1024, FF};
  pg8::EpiStore E{(u16*)(p.ws + WS_H), 1024, 0, nullptr};
  pg8::gemm_phase(TIDX, ldsl, g, E);
}
DEVI void phase_gin(const int TIDX, const Params& p, LAS unsigned char* ldsl) {
  pg8::Gemm g{(const u16*)(p.ws + WS_XB), (const u16*)(p.ws + WS_WIN), T, 2048, 1024};
  pg8::EpiStore E{(u16*)(p.ws + WS_BIG), 2048, 4, (const float*)(p.ws + WS_STAT)};
  pg8::gemm_phase(TIDX, ldsl, g, E);
}
DEVI void phase_gout(const int TIDX, const Params& p, int layer, LAS unsigned char* ldsl) {
  pg8::Gemm g{(const u16*)(p.ws + WS_H), (const u16*)(p.ws + WS_WOUT) + (size_t)layer * 1024 * 1024, T, 1024, 1024};
  pg8::EpiStore E{(u16*)(p.ws + WS_BIG), 1024, 0, nullptr};
  pg8::gemm_phase(TIDX, ldsl, g, E);
}

DEVI void phase_sgu(const int TIDX, const Params& p, u16* lds) {
  const int SB = TIDX >> 8, TID = TIDX & 255;
  lds += SB * 32768;
  const u16* vt = (const u16*)(p.ws + WS_BIG) + (size_t)T * 2048;
  const u16* sgw = (const u16*)(p.ws + WS_SGW);
  const u16* proj = (const u16*)(p.ws + WS_BIG);
  u16* cat = (u16*)(p.ws + WS_H);
  const int ntiles = 768;
  const int lane = TID & 63, wave = TID >> 6, wm = wave >> 1, wn = wave & 1;
  for (int t = 2 * blockIdx.x + SB; t < ntiles; t += 2 * gridDim.x) {
    int mt, nt;
    tile_map(t, 1, mt, nt);
    const int head = mt / 192;
    f32x16 acc[4][2];
    const long arow0 = (long)mt * 256;
    gemm_mainloop(TID, vt, [=](int r) { return (arow0 + r) * 128; }, sgw + head * 128 * 128, 128, 128, lds, acc);
#pragma unroll
    for (int nb = 0; nb < 2; ++nb) {
      const int q = wn * 64 + nb * 32 + (lane & 31);
      const float bias = p.sg_b[head * 128 + q];
#pragma unroll
      for (int mb = 0; mb < 4; ++mb)
#pragma unroll
        for (int rg = 0; rg < 4; ++rg) {
          int rh = (mt % 192) * 256 + wm * 128 + mb * 32 + rg * 8 + (lane >> 5) * 4;
          int chunk = rh >> 7, c = rh & 127;
          long token = (long)chunk * 128 + q;
          uint2 uv = *(const uint2*)(proj + token * 2048 + head * 128 + c);
          float o0 = (acc[mb][nb][rg * 4 + 0] + bias) * bf_lo(uv.x);
          float o1 = (acc[mb][nb][rg * 4 + 1] + bias) * bf_hi(uv.x);
          float o2 = (acc[mb][nb][rg * 4 + 2] + bias) * bf_lo(uv.y);
          float o3 = (acc[mb][nb][rg * 4 + 3] + bias) * bf_hi(uv.y);
          uint2 ov;
          ov.x = pack2(o0, o1);
          ov.y = pack2(o2, o3);
          *(uint2*)(cat + token * 1024 + head * 128 + c) = ov;
        }
    }
  }
}

template <bool SAMPLE>
DEVI void phase_f1(const int TIDX, const Params& p, u16* lds) {
  const int SB = TIDX >> 8, TID = TIDX & 255;
  lds += SB * 32768;
  const u16* H = (const u16*)(p.ws + WS_H);
  const u16* T1 = (const u16*)(p.ws + WS_T1);
  u16* Zt = (u16*)(p.ws + WS_BIG);
  const int NT = 16, MT = SAMPLE ? 128 : 64, ntiles = MT * NT;
  const int lane = TID & 63, wave = TID >> 6, wm = wave >> 1, wn = wave & 1;
  for (int t = 2 * blockIdx.x + SB; t < ntiles; t += 2 * gridDim.x) {
    int mt, nt;
    tile_map(t, NT, mt, nt);
    const int g = nt >> 2, nq = nt & 3;
    f32x16 acc[4][2];
    if (SAMPLE) {
      const long tb = TP + (long)(mt >> 3) * 2048 + 2 * (mt & 7);
      gemm_mainloop(TID, H, [=](int r) { return (tb + (long)(r & 127) * 16 + (r >> 7)) * 1024 + g * 256; },
                    T1 + (size_t)nq * 128 * 256, 256, 256, lds, acc);
    } else {
      const long tb = 2 * mt;
      gemm_mainloop(TID, H, [=](int r) { return (tb + (long)(r & 127) * 128 + (r >> 7)) * 1024 + g * 256; },
                    T1 + (size_t)nq * 128 * 256, 256, 256, lds, acc);
    }
    const int s = nq >> 1;
#pragma unroll
    for (int nb = 0; nb < 2; ++nb) {
      const int cp = g * 256 + (nq & 1) * 128 + wn * 64 + nb * 32 + (lane & 31);
      long rowz;
      if (SAMPLE) rowz = ((long)cp * 16 + (mt >> 3)) * 16 + 2 * (mt & 7) + wm;
      else rowz = (long)cp * 128 + 2 * mt + wm;
      u16* dst = Zt + (rowz * 2 + s) * 128;
#pragma unroll
      for (int mb = 0; mb < 4; ++mb)
#pragma unroll
        for (int rg = 0; rg < 4; ++rg) {
          int n1 = mb * 32 + rg * 8 + (lane >> 5) * 4;
          uint2 ov;
          ov.x = pack2(acc[mb][nb][rg * 4 + 0], acc[mb][nb][rg * 4 + 1]);
          ov.y = pack2(acc[mb][nb][rg * 4 + 2], acc[mb][nb][rg * 4 + 3]);
          *(uint2*)(dst + n1) = ov;
        }
    }
  }
}

template <bool SAMPLE>
DEVI void phase_fa(const int TIDX, const Params& p, u16* lds) {
  const int SB = TIDX >> 8, TID = TIDX & 255;
  lds += SB * 32768;
  const u16* Zt = (const u16*)(p.ws + WS_BIG);
  const u16* T2 = (const u16*)(p.ws + WS_T2);
  u16* Yt = (u16*)(p.ws + WS_BIG) + (SAMPLE ? (size_t)262144 * 256 : (size_t)131072 * 256);
  const int NT = 2, MT = SAMPLE ? 1024 : 512, ntiles = MT * NT;
  const int lane = TID & 63, wave = TID >> 6, wm = wave >> 1, wn = wave & 1;
  for (int t = 2 * blockIdx.x + SB; t < ntiles; t += 2 * gridDim.x) {
    int mt, nt;
    tile_map(t, NT, mt, nt);
    f32x16 acc[4][2];
    const long arow0 = (long)mt * 256;
    gemm_mainloop(TID, Zt, [=](int r) { return (arow0 + r) * 256; }, T2 + (size_t)nt * 128 * 256, 256, 256, lds, acc);
    const int k1 = 32 * (nt * 2 + wn) + (lane & 31);
#pragma unroll
    for (int mb = 0; mb < 4; ++mb)
#pragma unroll
      for (int rg = 0; rg < 4; ++rg) {
        const long row = arow0 + wm * 128 + mb * 32 + rg * 8 + (lane >> 5) * 4;
        float yr[4], yi[4];
        int n2;
        u16 *dre, *dim_;
        if (SAMPLE) {
          n2 = (int)(row & 15);
          int b = (int)((row >> 4) & 15);
          int cp = (int)(row >> 8);
          u16* base = Yt + ((((long)b * 128 + k1) * 1024 + cp) * 2) * 16 + n2;
          dre = base;
          dim_ = base + 16;
        } else {
          n2 = (int)(row & 127);
          int cp = (int)(row >> 7);
          u16* base = Yt + (((long)k1 * 1024 + cp) * 2) * 128 + n2;
          dre = base;
          dim_ = base + 128;
        }
#pragma unroll
        for (int i = 0; i < 4; ++i) {
          float re = acc[mb][0][rg * 4 + i], im = acc[mb][1][rg * 4 + i];
          float ang = (float)((n2 + i) * k1) * (SAMPLE ? (6.283185307179586f / 2048.f) : (6.283185307179586f / 16384.f));
          float ct = __cosf(ang), st = __sinf(ang);
          yr[i] = re * ct + im * st;
          yi[i] = im * ct - re * st;
        }
        uint2 o;
        o.x = pack2(yr[0], yr[1]);
        o.y = pack2(yr[2], yr[3]);
        *(uint2*)dre = o;
        o.x = pack2(yi[0], yi[1]);
        o.y = pack2(yi[2], yi[3]);
        *(uint2*)dim_ = o;
      }
  }
}

DEVI void phase_fb_prompt(const int TIDX, const Params& p, u16* lds) {
  const int SB = TIDX >> 8, TID = TIDX & 255;
  lds += SB * 32768;
  const u16* Yt = (const u16*)p.out;
  const u16* T3 = (const u16*)(p.ws + WS_T3);
  u16* f = (u16*)(p.ws + WS_H);
  const int ntiles = 512;
  const int lane = TID & 63, wave = TID >> 6, wm = wave >> 1, wn = wave & 1;
  for (int t = 2 * blockIdx.x + SB; t < ntiles; t += 2 * gridDim.x) {
    int mt, nt;
    tile_map(t, 1, mt, nt);
    f32x16 acc[4][2];
    const long arow0 = (long)mt * 256;
    gemm_mainloop(TID, Yt, [=](int r) { return (arow0 + r) * 256; }, T3, 256, 256, lds, acc);
#pragma unroll
    for (int nb = 0; nb < 2; ++nb) {
      const int k2 = wn * 64 + nb * 32 + (lane & 31);
#pragma unroll
      for (int mb = 0; mb < 4; ++mb)
#pragma unroll
        for (int rg = 0; rg < 4; ++rg) {
          long row = arow0 + wm * 128 + mb * 32 + rg * 8 + (lane >> 5) * 4;
          int k1 = (int)(row >> 10), cp = (int)(row & 1023);
          long token = k1 + 128 * k2;
          uint2 o;
          o.x = pack2(acc[mb][nb][rg * 4 + 0], acc[mb][nb][rg * 4 + 1]);
          o.y = pack2(acc[mb][nb][rg * 4 + 2], acc[mb][nb][rg * 4 + 3]);
          *(uint2*)(f + token * 1024 + cp) = o;
        }
    }
  }
}

DEVI void phase_fb_sample(const int TIDX, const Params& p) {
  const u16* Yt = (const u16*)p.out + (size_t)131072 * 256;
  u16* f = (u16*)(p.ws + WS_H);
  const int lane = TIDX & 63, wave = TIDX >> 6;
  const int col = lane & 15, kg = lane >> 4;
  bf16x8 bfrag;
#pragma unroll
  for (int j = 0; j < 8; ++j) {
    int k = kg * 8 + j, s = k >> 4, n2 = k & 15;
    int ph = (col * n2) & 15;
    float v = (s == 0 ? cospif((float)ph * 0.125f) : sinpif((float)ph * 0.125f)) * 0.25f;
    bfrag[j] = (short)f2bf(v);
  }
  const int G = 131072;
  const int nw = gridDim.x * 8;
  for (int g0 = blockIdx.x * 8 + wave; g0 < G; g0 += 4 * nw) {
    bf16x8 afrag[4];
#pragma unroll
    for (int i = 0; i < 4; ++i) {
      const long row0 = (long)(g0 + i * nw) * 16;
      afrag[i] = *(const bf16x8*)(Yt + (row0 + (lane & 15)) * 32 + kg * 8);
    }
#pragma unroll
    for (int i = 0; i < 4; ++i) {
      f32x4 acc = {0.f, 0.f, 0.f, 0.f};
      acc = __builtin_amdgcn_mfma_f32_16x16x32_bf16(afrag[i], bfrag, acc, 0, 0, 0);
      const long row = (long)(g0 + i * nw) * 16 + 4 * kg;
      const int cp = (int)(row & 1023), k1 = (int)((row >> 10) & 127), b = (int)(row >> 17);
      const long token = TP + (long)b * 2048 + k1 + 128 * col;
      uint2 o;
      o.x = pack2(acc[0], acc[1]);
      o.y = pack2(acc[2], acc[3]);
      *(uint2*)(f + token * 1024 + cp) = o;
    }
  }
}

DEVI void phase_norm(const int TIDX, const Params& p, int mode, const u16* y, float scale, const float* post_g) {
  u16* xb = (u16*)(p.ws + WS_XB);
  float* stat = (float*)(p.ws + WS_STAT);
  const int lane = TIDX & 63, wave = TIDX >> 6;
  const int stride = gridDim.x * 8;
  int row = blockIdx.x * 8 + wave;
  if (mode == 0) {
    for (; row < T; row += stride) {
      const float* xsrc = row < TP ? p.xp + (long)row * 1024 : p.xs + (long)(row - TP) * 1024;
      float ss = 0.f;
#pragma unroll
      for (int j = 0; j < 2; ++j) {
        const float4 a = *(const float4*)(xsrc + j * 512 + lane * 8), b = *(const float4*)(xsrc + j * 512 + lane * 8 + 4);
        ss += a.x * a.x + a.y * a.y + a.z * a.z + a.w * a.w + b.x * b.x + b.y * b.y + b.z * b.z + b.w * b.w;
        uint4 o;
        o.x = pack2(a.x, a.y); o.y = pack2(a.z, a.w); o.z = pack2(b.x, b.y); o.w = pack2(b.z, b.w);
        *(uint4*)(xb + (long)row * 1024 + j * 512 + lane * 8) = o;
      }
      ss = wave_sum(ss, lane);
      if (lane == 0) stat[row] = ss;
    }
    return;
  }
  float gp[2][8];
#pragma unroll
  for (int j = 0; j < 2; ++j) {
    const float4 g0 = *(const float4*)(post_g + j * 512 + lane * 8), g1 = *(const float4*)(post_g + j * 512 + lane * 8 + 4);
    gp[j][0] = g0.x * scale; gp[j][1] = g0.y * scale; gp[j][2] = g0.z * scale; gp[j][3] = g0.w * scale;
    gp[j][4] = g1.x * scale; gp[j][5] = g1.y * scale; gp[j][6] = g1.z * scale; gp[j][7] = g1.w * scale;
  }
  uint4 yv[2], xr[2];
  if (row < T) {
#pragma unroll
    for (int j = 0; j < 2; ++j) {
      yv[j] = *(const uint4*)(y + (long)row * 1024 + j * 512 + lane * 8);
      xr[j] = *(const uint4*)(xb + (long)row * 1024 + j * 512 + lane * 8);
    }
  }
  while (row < T) {
    const int nrow = row + stride;
    uint4 yn[2], xn[2];
    if (nrow < T) {
#pragma unroll
      for (int j = 0; j < 2; ++j) {
        yn[j] = *(const uint4*)(y + (long)nrow * 1024 + j * 512 + lane * 8);
        xn[j] = *(const uint4*)(xb + (long)nrow * 1024 + j * 512 + lane * 8);
      }
    } else {
#pragma unroll
      for (int j = 0; j < 2; ++j) { yn[j] = yv[j]; xn[j] = xr[j]; }
    }
    float xv[2][8], yf[2][8];
    float ss = 0.f;
#pragma unroll
    for (int j = 0; j < 2; ++j) {
      yf[j][0] = bf_lo(yv[j].x); yf[j][1] = bf_hi(yv[j].x); yf[j][2] = bf_lo(yv[j].y); yf[j][3] = bf_hi(yv[j].y);
      yf[j][4] = bf_lo(yv[j].z); yf[j][5] = bf_hi(yv[j].z); yf[j][6] = bf_lo(yv[j].w); yf[j][7] = bf_hi(yv[j].w);
      xv[j][0] = bf_lo(xr[j].x); xv[j][1] = bf_hi(xr[j].x); xv[j][2] = bf_lo(xr[j].y); xv[j][3] = bf_hi(xr[j].y);
      xv[j][4] = bf_lo(xr[j].z); xv[j][5] = bf_hi(xr[j].z); xv[j][6] = bf_lo(xr[j].w); xv[j][7] = bf_hi(xr[j].w);
#pragma unroll
      for (int e = 0; e < 8; ++e) ss += yf[j][e] * yf[j][e];
    }
    ss = wave_sum(ss, lane);
    const float r = rsqrtf(ss * (1.f / 1024.f) + EPS);
    float sx = 0.f;
#pragma unroll
    for (int j = 0; j < 2; ++j)
#pragma unroll
      for (int e = 0; e < 8; ++e) {
        xv[j][e] += yf[j][e] * r * gp[j][e];
        sx += xv[j][e] * xv[j][e];
      }
    if (mode == 2) {
#pragma unroll
      for (int j = 0; j < 2; ++j) {
        float4 a, b;
        a.x = xv[j][0]; a.y = xv[j][1]; a.z = xv[j][2]; a.w = xv[j][3]; b.x = xv[j][4]; b.y = xv[j][5]; b.z = xv[j][6]; b.w = xv[j][7];
        *(float4*)(p.out + (long)row * 1024 + j * 512 + lane * 8) = a;
        *(float4*)(p.out + (long)row * 1024 + j * 512 + lane * 8 + 4) = b;
      }
    } else {
#pragma unroll
      for (int j = 0; j < 2; ++j) {
        uint4 o;
        o.x = pack2(xv[j][0], xv[j][1]); o.y = pack2(xv[j][2], xv[j][3]); o.z = pack2(xv[j][4], xv[j][5]); o.w = pack2(xv[j][6], xv[j][7]);
        *(uint4*)(xb + (long)row * 1024 + j * 512 + lane * 8) = o;
      }
      sx = wave_sum(sx, lane);
      if (lane == 0) stat[row] = sx;
      if (mode == 3) {
        const float rx = rsqrtf(sx * (1.f / 1024.f) + EPS);
        u16* hrow = (u16*)(p.ws + WS_H) + (long)row * 1024;
#pragma unroll
        for (int j = 0; j < 2; ++j) {
          uint4 o;
          o.x = pack2(xv[j][0] * rx, xv[j][1] * rx); o.y = pack2(xv[j][2] * rx, xv[j][3] * rx);
          o.z = pack2(xv[j][4] * rx, xv[j][5] * rx); o.w = pack2(xv[j][6] * rx, xv[j][7] * rx);
          *(uint4*)(hrow + j * 512 + lane * 8) = o;
        }
      }
    }
#pragma unroll
    for (int j = 0; j < 2; ++j) { yv[j] = yn[j]; xr[j] = xn[j]; }
    row = nrow;
  }
}

DEVI void tconv_tile(const int TIDX, const float* __restrict__ src, int ldsrc, u16* __restrict__ dst, int lddst, int k0, int n0, int rm,
                     float* tl, const float* __restrict__ kscale) {
  const int tid = TIDX;
  {
    const int nn4 = (tid & 15) * 4, kk = tid >> 4;
#pragma unroll
    for (int i = 0; i < 4; ++i) {
      float4 v = *(const float4*)(src + (long)(k0 + kk + 16 * i) * ldsrc + n0 + nn4);
      const float ks = kscale ? kscale[k0 + kk + 16 * i] : 1.f;
      float* d = tl + (kk + 16 * i) * 65 + nn4;
      d[0] = v.x * ks; d[1] = v.y * ks; d[2] = v.z * ks; d[3] = v.w * ks;
    }
  }
  __syncthreads();
  {
    const int kk8 = (tid & 7) * 8, nn = tid >> 3;
#pragma unroll
    for (int i = 0; i < 2; ++i) {
      int n = nn + 32 * i;
      float v[8];
#pragma unroll
      for (int j = 0; j < 8; ++j) v[j] = tl[(kk8 + j) * 65 + n];
      uint4 o;
      o.x = pack2(v[0], v[1]); o.y = pack2(v[2], v[3]); o.z = pack2(v[4], v[5]); o.w = pack2(v[6], v[7]);
      int ng = n0 + n;
      int drow = (rm == 0) ? ng : (256 * (ng >> 7) + (ng & 127) + (rm == 2 ? 128 : 0));
      *(uint4*)(dst + (long)drow * lddst + k0 + kk8) = o;
    }
  }
  __syncthreads();
}

DEVI void prep_ffn_tile(const int TID, const Params& p, int f, int t, float* tl) {
  const int kind = t / 704, tt = t - kind * 704, j = f & 1;
  if (kind < 2) {
    const float* src = (kind ? p.w_up : p.w_gate) + (size_t)f * 1024 * 2816;
    u16* dst = (u16*)(p.ws + WS_WGU) + (size_t)j * 5632 * 1024;
    tconv_tile(TID, src, 2816, dst, 1024, (tt & 15) * 64, (tt >> 4) * 64, kind ? 2 : 1, tl, p.ffn_pre_g + f * 1024);
  } else {
    const float* src = p.w_down + (size_t)f * 2816 * 1024;
    u16* dst = (u16*)(p.ws + WS_WD) + (size_t)j * 1024 * 2816;
    tconv_tile(TID, src, 1024, dst, 2816, (tt % 44) * 64, (tt / 44) * 64, 0, tl, nullptr);
  }
}
DEVI void prep_ffn_in_tail(const int TIDX, const Params& p, int f, float* tl) {
  if (blockIdx.x < 128 || gridDim.x != 256) return;
  const int SB = TIDX >> 8, TID = TIDX & 255;
  tl += SB * 16384;
  for (int t = 2 * ((int)blockIdx.x - 128) + SB; t < 2112; t += 256) prep_ffn_tile(TID, p, f, t, tl);
}
DEVI void prep_ffn_all(const int TIDX, const Params& p, int f, float* tl) {
  const int SB = TIDX >> 8, TID = TIDX & 255;
  tl += SB * 16384;
  for (int t = 2 * blockIdx.x + SB; t < 2112; t += 2 * gridDim.x) prep_ffn_tile(TID, p, f, t, tl);
}
DEVI void phase_prep(const int TIDX, const Params& p, float* tl) {
  const int SB = TIDX >> 8, TID = TIDX & 255;
  tl += SB * 16384;
  const int ntiles = 2112 + 512 + 512;
  for (int t = 2 * blockIdx.x + SB; t < ntiles; t += 2 * gridDim.x) {
    if (t < 2112) {
      prep_ffn_tile(TID, p, 0, t, tl);
    } else if (t < 2624) {
      int tt = t - 2112;
      tconv_tile(TID, p.ab_w_in, 2048, (u16*)(p.ws + WS_WIN), 1024, (tt & 15) * 64, (tt >> 4) * 64, 0, tl, p.mix_pre_g);
    } else {
      int tt = t - 2624, i = tt >> 8, t2 = tt & 255;
      tconv_tile(TID, p.mix_w_out + (size_t)i * 1024 * 1024, 1024, (u16*)(p.ws + WS_WOUT) + (size_t)i * 1024 * 1024, 1024,
                 (t2 & 15) * 64, (t2 >> 4) * 64, 0, tl, nullptr);
    }
  }
  const int gtid = blockIdx.x * 512 + TIDX, nth = gridDim.x * 512;
  u16* sgw = (u16*)(p.ws + WS_SGW);
  u16* T1 = (u16*)(p.ws + WS_T1);
  u16* T2 = (u16*)(p.ws + WS_T2);
  u16* T3 = (u16*)(p.ws + WS_T3);
  for (int e = gtid; e < 65536 + 524288 + 65536 + 32768; e += nth) {
    if (e < 65536) {
      sgw[e] = f2bf(p.sg_w[e]);
    } else if (e < 65536 + 524288) {
      int i = e - 65536, grp = i >> 17, n = (i >> 8) & 511, k = i & 255;
      int s = n >> 8, m = n & 255;
      int ph = (m * k) & 255;
      float a = (float)ph * (1.f / 128.f);
      float v = (s == 0 ? cospif(a) : -sinpif(a)) * (1.f / 16.f) * p.mix_pre_g[1024 + grp * 256 + k];
      T1[i] = f2bf(v);
    } else if (e < 65536 + 524288 + 65536) {
      int i = e - 65536 - 524288, n = i >> 8, k = i & 255;
      int sp = n >> 7, k1 = n & 127;
      int s = k >> 7, n1 = k & 127;
      int ph = (k1 * n1) & 127;
      float a = (float)ph * (1.f / 64.f);
      float C = cospif(a), S = sinpif(a);
      float v = (sp == 0) ? (s == 0 ? C : S) : (s == 0 ? -S : C);
      T2[i] = f2bf(v * 0.08838834764831845f);
    } else {
      int i = e - 65536 - 524288 - 65536, k2 = i >> 8, k = i & 255;
      int s = k >> 7, n2 = k & 127;
      int ph = (k2 * n2) & 127;
      float a = (float)ph * (1.f / 64.f);
      float v = (s == 0 ? cospif(a) : sinpif(a)) * 0.08838834764831845f;
      T3[i] = f2bf(v);
    }
  }
}

DEVI void phase_lnv(const int TIDX, const Params& p, u16* ldt) {
  const int SB = TIDX >> 8, TID = TIDX & 255;
  ldt += SB * 32768;
  const u16* proj = (const u16*)(p.ws + WS_BIG);
  u16* vt = (u16*)(p.ws + WS_BIG) + (size_t)T * 2048;
  const int lane = TID & 63, wave = TID >> 6, tid = TID;
  constexpr int LR = 132;
  for (int t = 2 * blockIdx.x + SB; t < 1536; t += 2 * gridDim.x) {
    const int chunk = t >> 2, head = t & 3;
    const float g0 = p.sg_ln_g[head * 128 + lane], g1 = p.sg_ln_g[head * 128 + 64 + lane];
    const float b0 = p.sg_ln_b[head * 128 + lane], b1 = p.sg_ln_b[head * 128 + 64 + lane];
#pragma unroll 1
    for (int pb = 0; pb < 4; ++pb) {
      const int pos0 = wave * 32 + pb * 8;
      const u16* src0 = proj + ((long)chunk * 128 + pos0) * 2048 + 512;
      uint4 sv[8];
      u16 h0[8], h1[8];
#pragma unroll
      for (int i = 0; i < 8; ++i) {
        const u16* src = src0 + (long)i * 2048;
        sv[i] = *(const uint4*)(src + lane * 8);
        h0[i] = src[head * 128 + lane];
        h1[i] = src[head * 128 + 64 + lane];
      }
      float sm[8], sq[8];
#pragma unroll
      for (int i = 0; i < 8; ++i) {
        const float e0 = bf_lo(sv[i].x), e1 = bf_hi(sv[i].x), e2 = bf_lo(sv[i].y), e3 = bf_hi(sv[i].y);
        const float e4 = bf_lo(sv[i].z), e5 = bf_hi(sv[i].z), e6 = bf_lo(sv[i].w), e7 = bf_hi(sv[i].w);
        sm[i] = ((e0 + e1) + (e2 + e3)) + ((e4 + e5) + (e6 + e7));
        sq[i] = ((e0 * e0 + e1 * e1) + (e2 * e2 + e3 * e3)) + ((e4 * e4 + e5 * e5) + (e6 * e6 + e7 * e7));
      }
#pragma unroll
      for (int m = 32; m >= 1; m >>= 1) {
#pragma unroll
        for (int i = 0; i < 8; ++i) {
          sm[i] += shx(sm[i], m, lane);
          sq[i] += shx(sq[i], m, lane);
        }
      }
#pragma unroll
      for (int i = 0; i < 8; ++i) {
        const float mean = sm[i] * (1.f / 512.f);
        const float var = fmaxf(sq[i] * (1.f / 512.f) - mean * mean, 0.f);
        const float r = rsqrtf(var + EPS);
        ldt[lane * LR + pos0 + i] = f2bf((bf2f(h0[i]) - mean) * r * g0 + b0);
        ldt[(lane + 64) * LR + pos0 + i] = f2bf((bf2f(h1[i]) - mean) * r * g1 + b1);
      }
    }
    __syncthreads();
#pragma unroll
    for (int it = 0; it < 8; ++it) {
      int item = it * 256 + tid, pg = item & 15, c = item >> 4;
      const uint2* s2 = (const uint2*)(ldt + c * LR + pg * 8);
      uint2 lo = s2[0], hi = s2[1];
      uint4 o;
      o.x = lo.x; o.y = lo.y; o.z = hi.x; o.w = hi.y;
      *(uint4*)(vt + (((long)head * 384 + chunk) * 128 + c) * 128 + pg * 8) = o;
    }
    __syncthreads();
  }
}

template <int RR>
struct ConvRow {
  static DEVI void run(const u32* lc, int tid, const float (&w)[31][2], float (&o)[32][2]) {
    const u32 cv = lc[RR * 256 + tid];
    const float c0 = bf_lo(cv), c1 = bf_hi(cv);
#pragma unroll
    for (int j = 0; j < 31; ++j) {
      const int tt = RR - j;
      if (tt >= 0 && tt < 32) {
        o[tt][0] += w[j][0] * c0;
        o[tt][1] += w[j][1] * c1;
      }
    }
    ConvRow<RR + 1>::run(lc, tid, w, o);
  }
};
template <>
struct ConvRow<62> {
  static DEVI void run(const u32*, int, const float (&)[31][2], float (&)[32][2]) {}
};

DEVI void phase_conv(const int TIDX, const Params& p, unsigned char* ldsb) {
  const int SB = TIDX >> 8, TID = TIDX & 255;
  ldsb += SB * 65536;
  const u16* proj = (const u16*)(p.ws + WS_BIG);
  u16* cat = (u16*)(p.ws + WS_H);
  u32* lc = (u32*)ldsb;
  float* lf = (float*)ldsb;
  const int lane = TID & 63, wave = TID >> 6, tid = TID;
  float w[31][2];
#pragma unroll
  for (int j = 0; j < 31; ++j) {
    float2 wv = *(const float2*)(p.conv_w + j * 512 + 2 * tid);
    w[j][0] = wv.x;
    w[j][1] = wv.y;
  }
  const float2 cb = *(const float2*)(p.conv_b + 2 * tid);
  float lg[8], lb[8];
#pragma unroll
  for (int j = 0; j < 8; ++j) {
    lg[j] = p.conv_ln_g[lane * 8 + j];
    lb[j] = p.conv_ln_b[lane * 8 + j];
  }
  for (int t = 2 * blockIdx.x + SB; t < 1536; t += 2 * gridDim.x) {
    const int t0 = t * 32;
    int seq_lo, seq_hi;
    if (t0 < TP) { seq_lo = 0; seq_hi = TP; }
    else { seq_lo = TP + ((t0 - TP) >> 11) * 2048; seq_hi = seq_lo + 2048; }
#pragma unroll 1
    for (int r0 = 0; r0 < 64; r0 += 32) {
      u32 av[32], gv[32];
#pragma unroll
      for (int i = 0; i < 32; ++i) {
        const int tok = t0 - 15 + r0 + i;
        av[i] = 0; gv[i] = 0;
        if (r0 + i < 62 && tok >= seq_lo && tok < seq_hi) {
          av[i] = *(const u32*)(proj + (long)tok * 2048 + 1024 + 2 * tid);
          gv[i] = *(const u32*)(proj + (long)tok * 2048 + 1536 + 2 * tid);
        }
      }
#pragma unroll
      for (int i = 0; i < 32; ++i) {
        if (r0 + i < 62)
          lc[(r0 + i) * 256 + tid] = pack2(bf_lo(av[i]) * sigmoidf_(bf_lo(gv[i])), bf_hi(av[i]) * sigmoidf_(bf_hi(gv[i])));
      }
    }
    float o[32][2];
#pragma unroll
    for (int i = 0; i < 32; ++i) { o[i][0] = cb.x; o[i][1] = cb.y; }
    ConvRow<0>::run(lc, tid, w, o);
    __syncthreads();
#pragma unroll
    for (int i = 0; i < 32; ++i) {
      float2 ov; ov.x = o[i][0]; ov.y = o[i][1];
      *(float2*)(lf + i * 512 + 2 * tid) = ov;
    }
    __syncthreads();
#pragma unroll 1
    for (int ib = 0; ib < 2; ++ib) {
      float v[4][8], sm[4], sq[4];
#pragma unroll
      for (int i = 0; i < 4; ++i) {
        const int tl = wave * 8 + ib * 4 + i;
        const float4 v0 = *(const float4*)(lf + tl * 512 + lane * 8);
        const float4 v1 = *(const float4*)(lf + tl * 512 + lane * 8 + 4);
        v[i][0] = v0.x; v[i][1] = v0.y; v[i][2] = v0.z; v[i][3] = v0.w; v[i][4] = v1.x; v[i][5] = v1.y; v[i][6] = v1.z; v[i][7] = v1.w;
        sm[i] = ((v0.x + v0.y) + (v0.z + v0.w)) + ((v1.x + v1.y) + (v1.z + v1.w));
      }
#pragma unroll
      for (int m = 32; m >= 1; m >>= 1)
#pragma unroll
        for (int i = 0; i < 4; ++i) sm[i] += shx(sm[i], m, lane);
#pragma unroll
      for (int i = 0; i < 4; ++i) {
        const float mean = sm[i] * (1.f / 512.f);
        sq[i] = 0.f;
#pragma unroll
        for (int j = 0; j < 8; ++j) { v[i][j] -= mean; sq[i] += v[i][j] * v[i][j]; }
      }
#pragma unroll
      for (int m = 32; m >= 1; m >>= 1)
#pragma unroll
        for (int i = 0; i < 4; ++i) sq[i] += shx(sq[i], m, lane);
#pragma unroll
      for (int i = 0; i < 4; ++i) {
        const int tl = wave * 8 + ib * 4 + i;
        const float r = rsqrtf(sq[i] * (1.f / 512.f) + EPS);
#pragma unroll
        for (int j = 0; j < 8; ++j) v[i][j] = siluf_(v[i][j] * r * lg[j] + lb[j]);
        uint4 ov;
        ov.x = pack2(v[i][0], v[i][1]); ov.y = pack2(v[i][2], v[i][3]); ov.z = pack2(v[i][4], v[i][5]); ov.w = pack2(v[i][6], v[i][7]);
        *(uint4*)(cat + (long)(t0 + tl) * 1024 + 512 + lane * 8) = ov;
      }
    }
    __syncthreads();
  }
}

__global__ void __launch_bounds__(512, 2) fwd_megakernel(Params p) {
  cg::grid_group grid = cg::this_grid();
  extern __shared__ __attribute__((aligned(16))) unsigned char lds_raw[];
  u16* lds = (u16*)lds_raw;
  LAS unsigned char* ldsl = (LAS unsigned char*)lds_raw;
  __shared__ uint4 xb_words;
  if (threadIdx.x == 0) xb_words = make_uint4(0u, 0u, 0u, 0u);
  __syncthreads();
  const int wave_s = __builtin_amdgcn_readfirstlane((int)(threadIdx.x >> 6));
  XcdBarrier xb = xcd_barrier_post((int)threadIdx.x, (unsigned*)(p.ws + WS_BAR), (volatile LAS3 unsigned*)&xb_words);
#ifndef PROBE_DUP
#define PROBE_DUP 0
#endif
#if PROBE_DUP
  static constexpr unsigned char prog[] = {0, 1, 1, 2, 2, 3, 4, 4, 5, 6, 7, 7, 19, 17, 17, 18, 18, 35, 33, 33, 34, 34, 51, 8, 9, 10, 11, 12, 13, 23, 23, 67, 49, 49, 50, 50, 83};
#else
  static constexpr unsigned char prog[] = {0, 1, 2, 3, 4, 5, 6, 7, 19, 17, 18, 35, 33, 34, 51, 8, 9, 10, 23, 67, 49, 50, 83};
#endif
  constexpr int NPH = (int)sizeof(prog);
#pragma unroll 1
  for (int ph = 0; ph < NPH; ++ph) {
    const int op = prog[ph] & 15, arg = prog[ph] >> 4;
    const int reps = (op == 1 || op == 2 || op == 4 || op == 7) ? REP_BIG : ((op == 5 || op == 6 || op >= 8) ? REP_SMALL : 1);
    for (int rep = 0; rep < reps; ++rep) {
      if (rep) { int t2 = threadIdx.x; asm volatile("" : "+v"(t2)); xcd_barrier(t2, xb); }
      int tid = threadIdx.x;
      asm volatile("" : "+v"(tid));
    switch (op) {
        case 0:
          phase_prep(tid, p, (float*)lds_raw);
          phase_norm(tid, p, 0, nullptr, 0.f, nullptr);
          break;
        case 1:
          phase_g1(tid, p, arg, ldsl);
          if (arg < 3) {
            if (gridDim.x == 256) prep_ffn_in_tail(tid, p, arg + 1, (float*)lds_raw);
            else prep_ffn_all(tid, p, arg + 1, (float*)lds_raw);
          }
          break;
        case 2: phase_g2(tid, p, arg, ldsl); break;
        case 3: {
          const bool mix = (arg == 1 || arg == 4);
          const int fidx = (arg == 0) ? 0 : (arg == 2) ? 1 : (arg == 3) ? 2 : 3;
          const float* post = mix ? p.mix_post_g + (arg == 1 ? 0 : 1024) : p.ffn_post_g + fidx * 1024;
          phase_norm(tid, p, arg == 5 ? 2 : (arg == 3 ? 3 : 1), (const u16*)(p.ws + (mix ? WS_BIG : WS_H)), mix ? 1.0f : 0.5f, post);
        } break;
        case 4: phase_gin(tid, p, ldsl); break;
        case 5:
          phase_lnv(tid, p, lds);
          phase_conv(tid, p, lds_raw);
          break;
        case 6: phase_sgu(tid, p, lds); break;
        case 7: phase_gout(tid, p, arg, ldsl); break;
        case 8: {
          unsigned am0 = ~0u; asm volatile("" : "+s"(am0)); int t2 = wave_s * 64 + (int)__builtin_amdgcn_mbcnt_hi(am0, __builtin_amdgcn_mbcnt_lo(am0, 0u)); asm volatile("" : "+v"(t2));
          phase_f1_pg8<false>(t2, p, ldsl);
          unsigned am = ~0u; asm volatile("" : "+s"(am)); int t3 = wave_s * 64 + (int)__builtin_amdgcn_mbcnt_hi(am, __builtin_amdgcn_mbcnt_lo(am, 0u)); asm volatile("" : "+v"(t3));
          phase_f1_pg8<true>(t3, p, ldsl);
        } break;
        case 9: {
          unsigned am0 = ~0u; asm volatile("" : "+s"(am0)); int t2 = wave_s * 64 + (int)__builtin_amdgcn_mbcnt_hi(am0, __builtin_amdgcn_mbcnt_lo(am0, 0u)); asm volatile("" : "+v"(t2));
          phase_fa_pg8<false>(t2, p, ldsl);
          unsigned am = ~0u; asm volatile("" : "+s"(am)); int t3 = wave_s * 64 + (int)__builtin_amdgcn_mbcnt_hi(am, __builtin_amdgcn_mbcnt_lo(am, 0u)); asm volatile("" : "+v"(t3));
          phase_fa_pg8<true>(t3, p, ldsl);
        } break;
        default: {
          unsigned am0 = ~0u; asm volatile("" : "+s"(am0)); int t2 = wave_s * 64 + (int)__builtin_amdgcn_mbcnt_hi(am0, __builtin_amdgcn_mbcnt_lo(am0, 0u)); asm volatile("" : "+v"(t2));
          phase_fb_prompt(t2, p, lds);
          unsigned am = ~0u; asm volatile("" : "+s"(am)); int t3 = wave_s * 64 + (int)__builtin_amdgcn_mbcnt_hi(am, __builtin_amdgcn_mbcnt_lo(am, 0u)); asm volatile("" : "+v"(t3));
          phase_fb_sample(t3, p);
        } break;
      }
    }
    if (ph != NPH - 1) for (int rb = 0; rb < REP_BAR; ++rb) {
      if (p.ws == nullptr) grid_barrier(grid);
      { int t2 = threadIdx.x; asm volatile("" : "+v"(t2)); xcd_barrier(t2, xb); }
    }
  }
}

extern "C" void kernel_launch(void* const* d_in, const int* in_sizes, int n_in, void* d_out, int out_size, void* d_ws,
                              size_t ws_size, hipStream_t stream) {
  static int grid_blocks = 0;
  if (!grid_blocks) {
    int dev = 0, cus = 0, per_cu = 0;
    (void)hipGetDevice(&dev);
    (void)hipDeviceGetAttribute(&cus, hipDeviceAttributeMultiprocessorCount, dev);
    (void)hipFuncSetAttribute((const void*)fwd_megakernel, hipFuncAttributeMaxDynamicSharedMemorySize, 131072);
    (void)hipOccupancyMaxActiveBlocksPerMultiprocessor(&per_cu, fwd_megakernel, 512, 131072);
    if (per_cu > 1) per_cu = 1;
    if (per_cu < 1) per_cu = 1;
    grid_blocks = cus * per_cu;
    if (ws_size < WS_END) {
      fprintf(stderr, "workspace too small: %zu < %zu\n", ws_size, (size_t)WS_END);
      grid_blocks = -1;
    }
  }
  if (grid_blocks < 0) return;
  Params p{};
  p.xp = (const float*)d_in[0]; p.xs = (const float*)d_in[1]; p.ffn_pre_g = (const float*)d_in[2];
  p.w_gate = (const float*)d_in[3]; p.w_up = (const float*)d_in[4]; p.w_down = (const float*)d_in[5];
  p.ffn_post_g = (const float*)d_in[6]; p.mix_pre_g = (const float*)d_in[7]; p.mix_w_out = (const float*)d_in[8];
  p.mix_post_g = (const float*)d_in[9]; p.ab_w_in = (const float*)d_in[10]; p.sg_ln_g = (const float*)d_in[11];
  p.sg_ln_b = (const float*)d_in[12]; p.sg_w = (const float*)d_in[13]; p.sg_b = (const float*)d_in[14];
  p.conv_w = (const float*)d_in[15]; p.conv_b = (const float*)d_in[16]; p.conv_ln_g = (const float*)d_in[17];
  p.conv_ln_b = (const float*)d_in[18];
  p.out = (float*)d_out;
  p.ws = (unsigned char*)d_ws;
  (void)hipMemsetAsync((unsigned char*)d_ws + WS_BAR, 0, 16384, stream);
  void* args[] = {&p};
  hipError_t e = hipLaunchCooperativeKernel((void*)fwd_megakernel, dim3(grid_blocks), dim3(512), args, 131072, stream);
  if (e != hipSuccess) fprintf(stderr, "cooperative launch failed: %s (grid %d)\n", hipGetErrorString(e), grid_blocks);
}
```

```cpp
#include <hip/hip_runtime.h>
#include <hip/hip_bf16.h>
#include <hip/hip_cooperative_groups.h>
#include <cstdio>
namespace cg = cooperative_groups;

typedef unsigned short u16;
typedef unsigned int u32;
typedef __attribute__((ext_vector_type(8))) short bf16x8;
typedef __attribute__((ext_vector_type(16))) float f32x16;
typedef __attribute__((ext_vector_type(4))) float f32x4;
#define DEVI __device__ __forceinline__

#ifndef REP_BIG
#define REP_BIG 1
#endif
#ifndef REP_SMALL
#define REP_SMALL 1
#endif
#ifndef REP_BAR
#define REP_BAR 1
#endif
constexpr int T = 49152;
constexpr int TP = 16384;
constexpr int D = 1024;
constexpr int FF = 2816;
constexpr float EPS = 1e-6f;

constexpr size_t WS_WGU = 0;
constexpr size_t WS_WD = WS_WGU + (size_t)2 * 5632 * 1024 * 2;
constexpr size_t WS_WIN = WS_WD + (size_t)2 * 1024 * 2816 * 2;
constexpr size_t WS_WOUT = WS_WIN + (size_t)2048 * 1024 * 2;
constexpr size_t WS_SGW = WS_WOUT + (size_t)2 * 1024 * 1024 * 2;
constexpr size_t WS_T1 = WS_SGW + (size_t)4 * 128 * 128 * 2;
constexpr size_t WS_T2 = WS_T1 + (size_t)4 * 512 * 256 * 2;
constexpr size_t WS_T3 = WS_T2 + (size_t)256 * 256 * 2;
constexpr size_t WS_STAT = WS_T3 + (size_t)128 * 256 * 2;
constexpr size_t WS_H = WS_STAT + (size_t)T * 4;
constexpr size_t WS_XB = WS_H + (size_t)T * 1024 * 2;
constexpr size_t WS_BIG = WS_XB + (size_t)T * 1024 * 2;
constexpr size_t WS_BAR = WS_BIG + (size_t)T * 2816 * 2;
constexpr size_t WS_END = WS_BAR + 16384;

struct Params {
  const float *xp, *xs, *ffn_pre_g, *w_gate, *w_up, *w_down, *ffn_post_g, *mix_pre_g, *mix_w_out, *mix_post_g,
      *ab_w_in, *sg_ln_g, *sg_ln_b, *sg_w, *sg_b, *conv_w, *conv_b, *conv_ln_g, *conv_ln_b;
  float* out;
  unsigned char* ws;
};

typedef __bf16 bf2v __attribute__((ext_vector_type(2)));
typedef float f2v __attribute__((ext_vector_type(2)));
DEVI u32 pack2(float lo, float hi) {
  f2v v = {lo, hi};
  bf2v r = __builtin_convertvector(v, bf2v);
  return __builtin_bit_cast(u32, r);
}
DEVI void grid_barrier(cg::grid_group& grid) {
  asm volatile("s_waitcnt vmcnt(0) lgkmcnt(0)" ::: "memory");
  grid.sync();
  __builtin_amdgcn_fence(__ATOMIC_ACQUIRE, "agent");
  asm volatile("s_waitcnt vmcnt(0)" ::: "memory");
}
DEVI u16 f2bf(float f) { return (u16)(pack2(f, 0.f) & 0xffffu); }
DEVI float bf_lo(u32 v) { return __uint_as_float(v << 16); }
DEVI float bf_hi(u32 v) { return __uint_as_float(v & 0xffff0000u); }
DEVI float bf2f(u16 h) { return __uint_as_float(((u32)h) << 16); }
typedef unsigned u32x4_nt __attribute__((ext_vector_type(4)));
DEVI float4 ntload_f4(const float* p) { const f32x4 v = __builtin_nontemporal_load((const f32x4*)p); float4 r; r.x = v[0]; r.y = v[1]; r.z = v[2]; r.w = v[3]; return r; }
DEVI uint4 ntload_u4(const u16* p) { const u32x4_nt v = __builtin_nontemporal_load((const u32x4_nt*)p); uint4 r; r.x = v[0]; r.y = v[1]; r.z = v[2]; r.w = v[3]; return r; }
DEVI void ntstore_f4(float* p, float4 a) { f32x4 v; v[0] = a.x; v[1] = a.y; v[2] = a.z; v[3] = a.w; __builtin_nontemporal_store(v, (f32x4*)p); }
DEVI float shx(float v, int m, int lane) {
  return __int_as_float(__builtin_amdgcn_ds_bpermute(((lane ^ m) & 63) << 2, __float_as_int(v)));
}
DEVI float wave_sum(float v, int lane) {
#pragma unroll
  for (int m = 32; m >= 1; m >>= 1) v += shx(v, m, lane);
  return v;
}
DEVI float sigmoidf_(float x) { return __builtin_amdgcn_rcpf(1.f + __builtin_amdgcn_exp2f(-1.4426950408889634f * x)); }
DEVI float siluf_(float x) { return x * sigmoidf_(x); }
DEVI float geluf_(float x) {
  const float u2 = 1.5957691216057308f * (x + 0.044715f * x * x * x);
  return x * sigmoidf_(u2);
}


#define XB_TMO      128
#define XB_XCNT(j)  (256  + 64 * (j))
#define XB_XSUB(j)  (1280 + 64 * (j))
#define XB_XGEN(j)  (2304 + 64 * (j))
#define XB_TOP      3328
#define XB_TOPGEN   3392
#define XCD_BAR_WORDS 3456
#define XB_SPIN_CAP (1u << 20)
#define LAS3 __attribute__((address_space(3)))
DEVI unsigned xb_ld(unsigned* p) { return __hip_atomic_load(p, __ATOMIC_RELAXED, __HIP_MEMORY_SCOPE_AGENT); }
DEVI unsigned xb_add(unsigned* p, unsigned v) { return __hip_atomic_fetch_add(p, v, __ATOMIC_RELAXED, __HIP_MEMORY_SCOPE_AGENT); }
DEVI unsigned xb_xcc_id() { return (unsigned)__builtin_amdgcn_s_getreg((3 << 11) | 20) & 0xFu; }
#define XB_SPIN(cond, bar) do { unsigned _sp = 0; while (cond) { __builtin_amdgcn_s_sleep(1); \
    if ((++_sp & 255u) == 0u) { if (xb_ld(&(bar)[XB_TMO])) break; if (_sp > XB_SPIN_CAP) { atomicAdd(&(bar)[XB_TMO], 1u); break; } } } } while (0)
struct XcdBarrier { unsigned* bar; unsigned x; volatile LAS3 unsigned* st; };
DEVI XcdBarrier xcd_barrier_post(const int TIDX, unsigned* bar, volatile LAS3 unsigned* st) {
  XcdBarrier b; b.bar = bar; b.x = xb_xcc_id(); b.st = st;
  if (TIDX == 0) (void)xb_add(&bar[XB_XCNT(b.x)], 1u);
  return b;
}
DEVI void xcd_barrier_complete(unsigned* bar, unsigned x, unsigned& nloc, unsigned& nx) {
  const unsigned G = gridDim.x * gridDim.y * gridDim.z;
  unsigned sum, cnt, mine, sp = 0u;
  for (;;) {
    sum = 0u; cnt = 0u; mine = 0u;
#pragma unroll
    for (unsigned j = 0; j < 16; ++j) { const unsigned c = xb_ld(&bar[XB_XCNT(j)]); sum += c; cnt += (c > 0u) ? 1u : 0u; mine = (j == x) ? c : mine; }
    if (sum == G) break;
    __builtin_amdgcn_s_sleep(1);
    if ((++sp & 255u) == 0u) { if (xb_ld(&bar[XB_TMO])) break; if (sp > XB_SPIN_CAP) { atomicAdd(&bar[XB_TMO], 1u); break; } }
  }
  nloc = mine > 0u ? mine : 1u; nx = cnt > 0u ? cnt : 1u;
}
DEVI void xcd_barrier(const int TIDX, const XcdBarrier& b) {
  asm volatile("s_waitcnt vmcnt(0) lgkmcnt(0)" ::: "memory");
  __syncthreads();
  if (TIDX == 0) {
    unsigned* bar = b.bar;
    __builtin_amdgcn_s_waitcnt(0);
    unsigned nloc = b.st[0], nx = b.st[1];
    if (nloc == 0u) { xcd_barrier_complete(bar, b.x, nloc, nx); b.st[0] = nloc; b.st[1] = nx; }
    const unsigned old = xb_add(&bar[XB_XSUB(b.x)], 1u);
    const unsigned gen = old / nloc;
    if (old + 1u == (gen + 1u) * nloc) {
      __builtin_amdgcn_fence(__ATOMIC_RELEASE, "agent");
      asm volatile("s_waitcnt vmcnt(0)" ::: "memory");
      const unsigned og = xb_add(&bar[XB_TOP], 1u);
      const unsigned tg = og / nx;
      if (og + 1u == (tg + 1u) * nx) xb_add(&bar[XB_TOPGEN], 1u);
      else XB_SPIN(xb_ld(&bar[XB_TOPGEN]) == tg, bar);
      __builtin_amdgcn_fence(__ATOMIC_ACQUIRE, "agent");
      xb_add(&bar[XB_XGEN(b.x)], 1u);
      asm volatile("s_waitcnt vmcnt(0)" ::: "memory");
    } else {
      XB_SPIN(xb_ld(&bar[XB_XGEN(b.x)]) == gen, bar);
      __builtin_amdgcn_fence(__ATOMIC_ACQUIRE, "agent");
      asm volatile("s_waitcnt vmcnt(0)" ::: "memory");
    }
  }
  __syncthreads();
}

constexpr int BM = 256, BN = 128, BK = 32;
constexpr int LROW = 40;
constexpr int A_BUF = BM * LROW;
constexpr int STAGE = (BM + BN) * LROW;

DEVI void tile_map(int t, int NT, int& mt, int& nt) {
  int xcd = t & 7, s = t >> 3;
  int per = 8 * NT;
  int mgl = s / per, rem = s - mgl * per;
  nt = rem >> 3;
  mt = ((mgl * 8 + xcd) << 3) + (rem & 7);
}

template <class AOff>
DEVI void gemm_mainloop(const int TIDX, const u16* __restrict__ A, AOff aoff, const u16* __restrict__ B, long ldb, int K, u16* lds,
                        f32x16 (&acc)[4][2]) {
  const int tid = TIDX, lane = tid & 63, wave = tid >> 6;
  const int wm = wave >> 1, wn = wave & 1;
  const int c4 = tid & 3, r0 = tid >> 2;
  const u16* ap[4];
  const u16* bp[2];
#pragma unroll
  for (int i = 0; i < 4; ++i) ap[i] = A + aoff(r0 + 64 * i) + c4 * 8;
#pragma unroll
  for (int i = 0; i < 2; ++i) bp[i] = B + (long)(r0 + 64 * i) * ldb + c4 * 8;
#pragma unroll
  for (int mb = 0; mb < 4; ++mb)
#pragma unroll
    for (int nb = 0; nb < 2; ++nb)
#pragma unroll
      for (int j = 0; j < 16; ++j) acc[mb][nb][j] = 0.f;

  uint4 ra[4], rb[2];
  const int nk = K / BK;
#pragma unroll
  for (int i = 0; i < 4; ++i) ra[i] = *(const uint4*)(ap[i]);
#pragma unroll
  for (int i = 0; i < 2; ++i) rb[i] = *(const uint4*)(bp[i]);
  {
    u16* st = lds;
#pragma unroll
    for (int i = 0; i < 4; ++i) *(uint4*)(st + (r0 + 64 * i) * LROW + c4 * 8) = ra[i];
#pragma unroll
    for (int i = 0; i < 2; ++i) *(uint4*)(st + A_BUF + (r0 + 64 * i) * LROW + c4 * 8) = rb[i];
  }
  __syncthreads();
  for (int kt = 0; kt < nk; ++kt) {
    const bool more = (kt + 1 < nk);
    if (more) {
#pragma unroll
      for (int i = 0; i < 4; ++i) ra[i] = *(const uint4*)(ap[i] + (kt + 1) * BK);
#pragma unroll
      for (int i = 0; i < 2; ++i) rb[i] = *(const uint4*)(bp[i] + (kt + 1) * BK);
    }
    const u16* st = lds + (kt & 1) * STAGE;
    const u16* sa = st + (wm * 128 + (lane & 31)) * LROW + (lane >> 5) * 8;
    const u16* sb = st + A_BUF + (wn * 64 + (lane & 31)) * LROW + (lane >> 5) * 8;
#pragma unroll
    for (int ks = 0; ks < 2; ++ks) {
      bf16x8 af[4], bfr[2];
#pragma unroll
      for (int mb = 0; mb < 4; ++mb) af[mb] = *(const bf16x8*)(sa + mb * 32 * LROW + ks * 16);
#pragma unroll
      for (int nb = 0; nb < 2; ++nb) bfr[nb] = *(const bf16x8*)(sb + nb * 32 * LROW + ks * 16);
#pragma unroll
      for (int mb = 0; mb < 4; ++mb)
#pragma unroll
        for (int nb = 0; nb < 2; ++nb)
          acc[mb][nb] = __builtin_amdgcn_mfma_f32_32x32x16_bf16(af[mb], bfr[nb], acc[mb][nb], 0, 0, 0);
    }
    if (more) {
      u16* sw = lds + ((kt + 1) & 1) * STAGE;
#pragma unroll
      for (int i = 0; i < 4; ++i) *(uint4*)(sw + (r0 + 64 * i) * LROW + c4 * 8) = ra[i];
#pragma unroll
      for (int i = 0; i < 2; ++i) *(uint4*)(sw + A_BUF + (r0 + 64 * i) * LROW + c4 * 8) = rb[i];
    }
    __syncthreads();
  }
}


DEVI void epi_store_rm(const int TIDX, f32x16 (&acc)[4][2], u16* dst, long ld, long row0, int col0, bool GELU) {
  const int lane = TIDX & 63, wave = TIDX >> 6, wm = wave >> 1, wn = wave & 1;
#pragma unroll
  for (int mb = 0; mb < 4; ++mb)
#pragma unroll
    for (int nb = 0; nb < 2; ++nb)
#pragma unroll
      for (int rg = 0; rg < 4; ++rg)
#pragma unroll
        for (int i = 0; i < 4; ++i) {
          long row = row0 + wm * 128 + mb * 32 + rg * 8 + (lane >> 5) * 4 + i;
          int col = col0 + wn * 64 + nb * 32 + (lane & 31);
          float v = acc[mb][nb][rg * 4 + i];
          if (GELU) v = geluf_(v);
          dst[row * ld + col] = f2bf(v);
        }
}


#define LAS __attribute__((address_space(3)))
typedef unsigned u32x4 __attribute__((ext_vector_type(4)));
namespace pg8 {
constexpr int BM = 256, BK = 64, HALF = 128, HTB = HALF * BK * 2, STAGE_BYTES = 8 * HTB, NXCD = 8, WGM = 4;
DEVI int lds_byte(int r, int c) { const int st = (r >> 4) * 2 + (c >> 5), rr = r & 15, cc = c & 31, ob = rr * 64 + cc * 2; return st * 1024 + (ob ^ (((ob >> 9) & 1) << 5)); }
DEVI void stage_rc(int b, int& R, int& C) { const int st = b / 1024, sb = b % 1024, swz = sb ^ (((sb >> 9) & 1) << 5); R = (st >> 1) * 16 + swz / 64; C = (st & 1) * 32 + (swz % 64) / 2; }
DEVI int perm32(int rho) { const int n = rho >> 4, i = rho & 15; return 8 * (i >> 2) + 4 * n + (i & 3); }
struct Unit { int pm, pn; };
struct Gemm { const u16* A; const u16* Bt; int M, N, K; };
struct StaticOrder {
  int nM, nN, nwg, G, c;
  DEVI void init(int M, int N, int G_, int c_) { nM = M / BM; nN = N / BM; nwg = nM * nN; G = G_; c = c_; }
  DEVI bool next(int i, Unit& u) const {
    const long L = (long)i * G + c; if (L >= nwg) return false;
    int wgid = (int)L; { const int q = nwg / NXCD, r = nwg % NXCD, xcd = wgid % NXCD, off = wgid / NXCD; wgid = (xcd < r ? xcd * (q + 1) : r * (q + 1) + (xcd - r) * q) + off; }
    const int nig = WGM * nN, gid = wgid / nig, fm = gid * WGM, gsz = (nM - fm) < WGM ? (nM - fm) : WGM;
    u.pm = fm + ((wgid % nig) % gsz); u.pn = (wgid % nig) / gsz; return true;
  }
};
struct AddrPlain {
  const char *A, *B; unsigned rowA, rowB; size_t hA, hB;
  DEVI AddrPlain(const u16* A_, const u16* B_, int K) : A((const char*)A_), B((const char*)B_), rowA(K * 2), rowB(K * 2), hA((size_t)HALF * K * 2), hB((size_t)HALF * K * 2) {}
  DEVI const char* a(const Unit& u) const { return A + (size_t)u.pm * 2 * hA; }
  DEVI const char* b(const Unit& u) const { return B + (size_t)u.pn * 2 * hB; }
};
template <class Epi, class Addr>
DEVI void gemm_phase_ad(const int TIDX, LAS unsigned char* lds, const Gemm g, const Addr& ad, const Epi& E) {
  const int tid = TIDX, wid = __builtin_amdgcn_readfirstlane(tid >> 6), lane = tid & 63, wr = wid >> 2, wc = wid & 3, fr = lane & 15, fq = lane >> 4;
  const int K = g.K, nt = K / BK;
  StaticOrder S; S.init(g.M, g.N, (int)gridDim.x, (int)blockIdx.x);
  unsigned voffA[2], voffB[2];
#pragma unroll
  for (int i = 0; i < 2; ++i) { int R, C; stage_rc(tid * 16 + i * 8192, R, C); const int Rb = Epi::PERM ? ((R & ~31) + perm32(R & 31)) : R;
    voffA[i] = (unsigned)R * ad.rowA + (unsigned)C * 2u; voffB[i] = (unsigned)Rb * ad.rowB + (unsigned)C * 2u; }
  const size_t kstep = (size_t)(BK * 2);
  const size_t hstepA = ad.hA, hstepB = ad.hB;
  const unsigned ldsw = (unsigned)wid * 1024u;
  const int aoff = lds_byte(wr * 64 + fr, fq * 8), boff = lds_byte(wc * 32 + fr, fq * 8);
#define PG8_SA(b, h) (((b) * 2 + (h)) * HTB)
#define PG8_SB(b, h) ((4 + (b) * 2 + (h)) * HTB)
#define PG8_STAGE(bufoff, gbase, voff) do { _Pragma("unroll") for (int _i = 0; _i < 2; ++_i) \
    __builtin_amdgcn_global_load_lds((const unsigned*)((const char*)(gbase) + (voff)[_i]), (LAS unsigned*)(lds + (bufoff) + ldsw + _i * 8192), 16, 0, 0); } while (0)
#define PG8_LDA(dst, b, h) do { _Pragma("unroll") for (int m = 0; m < 4; ++m) _Pragma("unroll") for (int k = 0; k < 2; ++k) dst[m][k] = *(const LAS bf16x8*)(lds + PG8_SA(b, h) + aoff + m * 2048 + k * 1024); } while (0)
#define PG8_LDB(dst, b, h) do { _Pragma("unroll") for (int n = 0; n < 2; ++n) _Pragma("unroll") for (int k = 0; k < 2; ++k) dst[n][k] = *(const LAS bf16x8*)(lds + PG8_SB(b, h) + boff + n * 2048 + k * 1024); } while (0)
#define PG8_MMA(ai, bj, At, Bt) do { __builtin_amdgcn_s_setprio(1); _Pragma("unroll") for (int m = 0; m < 4; ++m) _Pragma("unroll") for (int n = 0; n < 2; ++n) _Pragma("unroll") for (int k = 0; k < 2; ++k) \
    acc[ai][bj][m][n] = __builtin_amdgcn_mfma_f32_16x16x32_bf16(Bt[n][k], At[m][k], acc[ai][bj][m][n], 0, 0, 0); __builtin_amdgcn_s_setprio(0); } while (0)
#define PG8_WAIT_V(n) asm volatile("s_waitcnt vmcnt(" #n ")" ::: "memory")
#define PG8_WAIT_L(n) asm volatile("s_waitcnt lgkmcnt(" #n ")" ::: "memory")
#define PG8_BAR __builtin_amdgcn_s_barrier()
#define PG8_SCHED __builtin_amdgcn_sched_barrier(0)
  Unit cur, nxt; int ui = 0;
  if (!S.next(0, cur)) return;
  f32x4 acc[2][2][4][2];
#pragma unroll
  for (int a = 0; a < 2; ++a)
#pragma unroll
    for (int b = 0; b < 2; ++b)
#pragma unroll
      for (int m = 0; m < 4; ++m)
#pragma unroll
        for (int n = 0; n < 2; ++n) acc[a][b][m][n] = (f32x4){0.f, 0.f, 0.f, 0.f};
  bf16x8 At[4][2], B0[2][2], B1[2][2];
  const char* cA = ad.a(cur); const char* cB = ad.b(cur);
  PG8_STAGE(PG8_SB(0, 0), cB, voffB); PG8_STAGE(PG8_SA(0, 0), cA, voffA); PG8_STAGE(PG8_SB(0, 1), cB + hstepB, voffB); PG8_STAGE(PG8_SA(0, 1), cA + hstepA, voffA);
  if (wr == 1) PG8_BAR;
  PG8_WAIT_V(4); PG8_BAR;
  PG8_STAGE(PG8_SB(1, 0), cB + kstep, voffB); PG8_STAGE(PG8_SA(1, 0), cA + kstep, voffA); PG8_STAGE(PG8_SB(1, 1), cB + hstepB + kstep, voffB);
  PG8_WAIT_V(6); PG8_BAR;
  for (;;) {
    const bool has_next = S.next(ui + 1, nxt);
    const char* nA = has_next ? ad.a(nxt) : cA; const char* nB = has_next ? ad.b(nxt) : cB;
    const typename Epi::Pre pre = E.prefetch(cur, wr, fr);
    for (int t = 0; t < nt; t += 2) {
      const bool last = (t == nt - 2);
      const char* a1 = cA + (size_t)(t + 1) * kstep;
      const char* a2 = last ? nA : cA + (size_t)(t + 2) * kstep; const char* b2 = last ? nB : cB + (size_t)(t + 2) * kstep;
      const char* a3 = a2 + kstep; const char* b3 = b2 + kstep;
      PG8_LDB(B0, 0, 0); PG8_SCHED; PG8_LDA(At, 0, 0); PG8_STAGE(PG8_SA(1, 1), a1 + hstepA, voffA);
      PG8_WAIT_L(8); PG8_BAR; PG8_WAIT_L(0); PG8_MMA(0, 0, At, B0); PG8_BAR; PG8_SCHED;
      PG8_LDB(B1, 0, 1); PG8_STAGE(PG8_SB(0, 0), b2, voffB);
      PG8_BAR; PG8_WAIT_L(0); PG8_MMA(0, 1, At, B1); PG8_BAR;
      PG8_LDA(At, 0, 1); PG8_STAGE(PG8_SA(0, 0), a2, voffA);
      PG8_BAR; PG8_WAIT_L(0); PG8_MMA(1, 0, At, B0); PG8_BAR; PG8_SCHED;
      PG8_STAGE(PG8_SB(0, 1), b2 + hstepB, voffB);
      PG8_WAIT_V(6); PG8_BAR; PG8_MMA(1, 1, At, B1); PG8_BAR;
      PG8_LDB(B0, 1, 0); PG8_SCHED; PG8_LDA(At, 1, 0); PG8_STAGE(PG8_SA(0, 1), a2 + hstepA, voffA);
      PG8_WAIT_L(8); PG8_BAR; PG8_WAIT_L(0); PG8_MMA(0, 0, At, B0); PG8_BAR; PG8_SCHED;
      PG8_LDB(B1, 1, 1); PG8_STAGE(PG8_SB(1, 0), b3, voffB);
      PG8_BAR; PG8_WAIT_L(0); PG8_MMA(0, 1, At, B1); PG8_BAR;
      PG8_LDA(At, 1, 1); PG8_STAGE(PG8_SA(1, 0), a3, voffA);
      PG8_BAR; PG8_WAIT_L(0); PG8_MMA(1, 0, At, B0); PG8_BAR; PG8_SCHED;
      PG8_STAGE(PG8_SB(1, 1), b3 + hstepB, voffB);
      PG8_WAIT_V(6); PG8_BAR; PG8_MMA(1, 1, At, B1); PG8_BAR;
    }
    E(acc, cur, wr, wc, fr, fq, pre);
    if (!has_next) break;
#pragma unroll
    for (int a = 0; a < 2; ++a)
#pragma unroll
      for (int b = 0; b < 2; ++b)
#pragma unroll
        for (int m = 0; m < 4; ++m)
#pragma unroll
          for (int n = 0; n < 2; ++n) acc[a][b][m][n] = (f32x4){0.f, 0.f, 0.f, 0.f};
    cur = nxt; cA = nA; cB = nB; ++ui;
  }
  PG8_WAIT_V(0);
  if (wr == 0) PG8_BAR;
  PG8_BAR;
#undef PG8_SA
#undef PG8_SB
#undef PG8_STAGE
#undef PG8_LDA
#undef PG8_LDB
#undef PG8_MMA
#undef PG8_WAIT_V
#undef PG8_WAIT_L
#undef PG8_BAR
#undef PG8_SCHED
}
template <class Epi>
DEVI void gemm_phase(const int TIDX, LAS unsigned char* lds, const Gemm g, const Epi& E) {
  AddrPlain ad(g.A, g.Bt, g.K);
  gemm_phase_ad(TIDX, lds, g, ad, E);
}
struct PreNone {};
struct PreRows { float s[2][4]; };
struct EpiSwiglu {
  static constexpr bool PERM = true;
  u16* act; const float* stat;
  typedef PreRows Pre;
  DEVI Pre prefetch(const Unit& u, int wr, int fr) const {
    Pre q;
#pragma unroll
    for (int ai = 0; ai < 2; ++ai)
#pragma unroll
      for (int m = 0; m < 4; ++m) q.s[ai][m] = stat[u.pm * BM + wr * 64 + fr + ai * HALF + m * 16];
    return q;
  }
  DEVI void operator()(const f32x4 (&acc)[2][2][4][2], const Unit& u, int wr, int wc, int fr, int fq, const Pre& pre) const {
    const int row0 = u.pm * BM + wr * 64 + fr, col0 = u.pn * 128 + wc * 32 + 8 * fq;
#pragma unroll
    for (int ai = 0; ai < 2; ++ai)
#pragma unroll
      for (int m = 0; m < 4; ++m) {
        const int row = row0 + ai * HALF + m * 16;
        const float r = rsqrtf(pre.s[ai][m] * (1.f / 1024.f) + EPS);
        const float rn = -1.4426950408889634f * r, rr = r * r;
        f32x4 o0, o1;
#pragma unroll
        for (int j = 0; j < 4; ++j) {
          const float g0 = acc[ai][0][m][0][j], g1 = acc[ai][0][m][1][j];
          o0[j] = (g0 * acc[ai][1][m][0][j]) * (rr * __builtin_amdgcn_rcpf(1.f + __builtin_amdgcn_exp2f(g0 * rn)));
          o1[j] = (g1 * acc[ai][1][m][1][j]) * (rr * __builtin_amdgcn_rcpf(1.f + __builtin_amdgcn_exp2f(g1 * rn)));
        }
        u32x4 w; w.x = pack2(o0[0], o0[1]); w.y = pack2(o0[2], o0[3]); w.z = pack2(o1[0], o1[1]); w.w = pack2(o1[2], o1[3]);
        __builtin_nontemporal_store(w, (u32x4*)(act + (size_t)row * FF + col0));
      }
  }
};
struct EpiStore {
  static constexpr bool PERM = true;
  u16* O; int ldc; int gelu_pn; const float* stat;
  typedef PreRows Pre;
  DEVI Pre prefetch(const Unit& u, int wr, int fr) const {
    Pre q;
#pragma unroll
    for (int ai = 0; ai < 2; ++ai)
#pragma unroll
      for (int m = 0; m < 4; ++m) q.s[ai][m] = stat ? stat[u.pm * BM + wr * 64 + fr + ai * HALF + m * 16] : 0.f;
    return q;
  }
  DEVI void operator()(const f32x4 (&acc)[2][2][4][2], const Unit& u, int wr, int wc, int fr, int fq, const Pre& pre) const {
    const int row0 = u.pm * BM + wr * 64 + fr, col0 = u.pn * BM + wc * 32 + 8 * fq;
    const bool ge = u.pn < gelu_pn;
#pragma unroll
    for (int ai = 0; ai < 2; ++ai)
#pragma unroll
      for (int m = 0; m < 4; ++m) {
        const int row = row0 + ai * HALF + m * 16;
        const float r = stat ? rsqrtf(pre.s[ai][m] * (1.f / 1024.f) + EPS) : 1.f;
        u16* rowp = O + (size_t)row * ldc + col0;
#pragma unroll
        for (int bj = 0; bj < 2; ++bj) {
          f32x4 v0 = acc[ai][bj][m][0] * r, v1 = acc[ai][bj][m][1] * r;
          if (ge) {
#pragma unroll
            for (int j = 0; j < 4; ++j) { v0[j] = geluf_(v0[j]); v1[j] = geluf_(v1[j]); }
          }
          u32x4 w; w.x = pack2(v0[0], v0[1]); w.y = pack2(v0[2], v0[3]); w.z = pack2(v1[0], v1[1]); w.w = pack2(v1[2], v1[3]);
          *(u32x4*)(rowp + bj * HALF) = w;
        }
      }
  }
};
template <bool SAMPLE>
struct AddrF1 {
  const char *A, *H; unsigned rowA, rowB; size_t hA, hB;
  DEVI AddrF1(const u16* T1, const u16* H_) : A((const char*)T1), H((const char*)H_), rowA(512), rowB((SAMPLE ? 16 : 128) * 2048), hA((size_t)128 * 512), hB(2048) {}
  DEVI const char* a(const Unit& u) const { const int g = SAMPLE ? (u.pn >> 7) : (u.pn >> 6); return A + (size_t)g * 512 * 512 + (size_t)u.pm * 256 * 512; }
  DEVI const char* b(const Unit& u) const {
    if (SAMPLE) { const int g = u.pn >> 7, bb = (u.pn >> 3) & 15, pair = u.pn & 7; return H + ((size_t)(TP + bb * 2048 + 2 * pair) * 1024 + g * 256) * 2; }
    const int g = u.pn >> 6, pair = u.pn & 63; return H + ((size_t)(2 * pair) * 1024 + g * 256) * 2;
  }
};
template <bool SAMPLE>
struct EpiF1 {
  static constexpr bool PERM = false;
  u16* Zt;
  typedef PreNone Pre;
  DEVI Pre prefetch(const Unit&, int, int) const { return Pre{}; }
  DEVI void operator()(const f32x4 (&acc)[2][2][4][2], const Unit& u, int wr, int wc, int fr, int fq, const Pre&) const {
    const int s = u.pm;
    const int g = SAMPLE ? (u.pn >> 7) : (u.pn >> 6);
    const int bb = (u.pn >> 3) & 15;
    const int pair = SAMPLE ? (u.pn & 7) : (u.pn & 63);
#pragma unroll
    for (int ai = 0; ai < 2; ++ai)
#pragma unroll
      for (int m = 0; m < 4; ++m) {
        const int cp = g * 256 + 128 * ai + 64 * wr + 16 * m + fr;
#pragma unroll
        for (int bj = 0; bj < 2; ++bj) {
          const int n2 = 2 * pair + bj;
          const long rowz = SAMPLE ? (((long)cp * 16 + bb) * 16 + n2) : ((long)cp * 128 + n2);
          u16* dst = Zt + (rowz * 2 + s) * 128 + 32 * wc + 4 * fq;
#pragma unroll
          for (int n = 0; n < 2; ++n) {
            const f32x4 v = acc[ai][bj][m][n];
            uint2 o; o.x = pack2(v[0], v[1]); o.y = pack2(v[2], v[3]);
            *(uint2*)(dst + 16 * n) = o;
          }
        }
      }
  }
};
template <bool SAMPLE>
struct EpiFA {
  static constexpr bool PERM = false;
  u16* Yt;
  typedef PreNone Pre;
  DEVI Pre prefetch(const Unit&, int, int) const { return Pre{}; }
  DEVI void operator()(const f32x4 (&acc)[2][2][4][2], const Unit& u, int wr, int wc, int fr, int fq, const Pre&) const {
    constexpr float W = SAMPLE ? (6.283185307179586f / 2048.f) : (6.283185307179586f / 16384.f);
#pragma unroll
    for (int m = 0; m < 4; ++m) {
      int k1 = 64 * wr + 16 * m + fr;
      asm volatile("" : "+v"(k1));
#pragma unroll
      for (int n = 0; n < 2; ++n) {
        const int n2 = SAMPLE ? 4 * fq : (32 * wc + 16 * n + 4 * fq);
        float ct[4], st[4];
#pragma unroll
        for (int j = 0; j < 4; ++j) {
          const float ang = (float)((n2 + j) * k1) * W;
          ct[j] = __cosf(ang);
          st[j] = __sinf(ang);
        }
#pragma unroll
        for (int bj = 0; bj < 2; ++bj) {
          unsigned off;
          if (SAMPLE) off = ((unsigned)((8 * bj + 2 * wc + n) * 128 + k1) * 1024u + (unsigned)u.pn) * 32u + (unsigned)n2;
          else off = (unsigned)k1 * 262144u + (unsigned)(2 * u.pn + bj) * 256u + (unsigned)n2;
          const f32x4 re = acc[0][bj][m][n], im = acc[1][bj][m][n];
          uint2 o;
          o.x = pack2(re[0] * ct[0] + im[0] * st[0], re[1] * ct[1] + im[1] * st[1]);
          o.y = pack2(re[2] * ct[2] + im[2] * st[2], re[3] * ct[3] + im[3] * st[3]);
          *(uint2*)(Yt + off) = o;
          o.x = pack2(im[0] * ct[0] - re[0] * st[0], im[1] * ct[1] - re[1] * st[1]);
          o.y = pack2(im[2] * ct[2] - re[2] * st[2], im[3] * ct[3] - re[3] * st[3]);
          *(uint2*)(Yt + off + (SAMPLE ? 16 : 128)) = o;
        }
        __builtin_amdgcn_sched_barrier(0);
      }
    }
  }
};
}

template <bool SAMPLE>
DEVI void phase_f1_pg8(const int TIDX, const Params& p, LAS unsigned char* ldsl) {
  pg8::Gemm g{nullptr, nullptr, 512, SAMPLE ? 131072 : 65536, 256};
  pg8::AddrF1<SAMPLE> ad((const u16*)(p.ws + WS_T1), (const u16*)(p.ws + WS_H));
  pg8::EpiF1<SAMPLE> E{(u16*)(p.ws + WS_BIG) + (SAMPLE ? (size_t)131072 * 256 : 0)};
  pg8::gemm_phase_ad(TIDX, ldsl, g, ad, E);
}
template <bool SAMPLE>
DEVI void phase_fa_pg8(const int TIDX, const Params& p, LAS unsigned char* ldsl) {
  pg8::Gemm g{(const u16*)(p.ws + WS_T2), (const u16*)(p.ws + WS_BIG) + (SAMPLE ? (size_t)131072 * 256 : 0), 256, SAMPLE ? 262144 : 131072, 256};
  pg8::EpiFA<SAMPLE> E{(u16*)p.out + (SAMPLE ? (size_t)131072 * 256 : 0)};
  pg8::gemm_phase(TIDX, ldsl, g, E);
}


DEVI void phase_g1(const int TIDX, const Params& p, int f, LAS unsigned char* ldsl) {
  pg8::Gemm g{(const u16*)(p.ws + WS_XB), (const u16*)(p.ws + WS_WGU) + (size_t)(f & 1) * 5632 * 1024, T, 5632, 1024};
  pg8::EpiSwiglu E{(u16*)(p.ws + WS_BIG), (const float*)(p.ws + WS_STAT)};
  pg8::gemm_phase(TIDX, ldsl, g, E);
}
DEVI void phase_g2(const int TIDX, const Params& p, int f, LAS unsigned char* ldsl) {
  pg8::Gemm g{(const u16*)(p.ws + WS_BIG), (const u16*)(p.ws + WS_WD) + (size_t)(f & 1) * 1024 * 2816, T, 1024, FF};
  pg8::EpiStore E{(u16*)(p.ws + WS_H), 1024, 0, nullptr};
  pg8::gemm_phase(TIDX, ldsl, g, E);
}
DEVI void phase_gin(const int TIDX, const Params& p, LAS unsigned char* ldsl) {
  pg8::Gemm g{(const u16*)(p.ws + WS_XB), (const u16*)(p.ws + WS_WIN), T, 2048, 1024};
  pg8::EpiStore E{(u16*)(p.ws + WS_BIG), 2048, 4, (const float*)(p.ws + WS_STAT)};
  pg8::gemm_phase(TIDX, ldsl, g, E);
}
DEVI void phase_gout(const int TIDX, const Params& p, int layer, LAS unsigned char* ldsl) {
  pg8::Gemm g{(const u16*)(p.ws + WS_H), (const u16*)(p.ws + WS_WOUT) + (size_t)layer * 1024 * 1024, T, 1024, 1024};
  pg8::EpiStore E{(u16*)(p.ws + WS_BIG), 1024, 0, nullptr};
  pg8::gemm_phase(TIDX, ldsl, g, E);
}

DEVI void phase_sgu(const int TIDX, const Params& p, u16* lds) {
  const int SB = TIDX >> 8, TID = TIDX & 255;
  lds += SB * 32768;
  const u16* vt = (const u16*)(p.ws + WS_BIG) + (size_t)T * 2048;
  const u16* sgw = (const u16*)(p.ws + WS_SGW);
  const u16* proj = (const u16*)(p.ws + WS_BIG);
  u16* cat = (u16*)(p.ws + WS_H);
  const int ntiles = 768;
  const int lane = TID & 63, wave = TID >> 6, wm = wave >> 1, wn = wave & 1;
  for (int t = 2 * blockIdx.x + SB; t < ntiles; t += 2 * gridDim.x) {
    int mt, nt;
    tile_map(t, 1, mt, nt);
    const int head = mt / 192;
    f32x16 acc[4][2];
    const long arow0 = (long)mt * 256;
    gemm_mainloop(TID, vt, [=](int r) { return (arow0 + r) * 128; }, sgw + head * 128 * 128, 128, 128, lds, acc);
#pragma unroll
    for (int nb = 0; nb < 2; ++nb) {
      const int q = wn * 64 + nb * 32 + (lane & 31);
      const float bias = p.sg_b[head * 128 + q];
#pragma unroll
      for (int mb = 0; mb < 4; ++mb)
#pragma unroll
        for (int rg = 0; rg < 4; ++rg) {
          int rh = (mt % 192) * 256 + wm * 128 + mb * 32 + rg * 8 + (lane >> 5) * 4;
          int chunk = rh >> 7, c = rh & 127;
          long token = (long)chunk * 128 + q;
          uint2 uv = *(const uint2*)(proj + token * 2048 + head * 128 + c);
          float o0 = (acc[mb][nb][rg * 4 + 0] + bias) * bf_lo(uv.x);
          float o1 = (acc[mb][nb][rg * 4 + 1] + bias) * bf_hi(uv.x);
          float o2 = (acc[mb][nb][rg * 4 + 2] + bias) * bf_lo(uv.y);
          float o3 = (acc[mb][nb][rg * 4 + 3] + bias) * bf_hi(uv.y);
          uint2 ov;
          ov.x = pack2(o0, o1);
          ov.y = pack2(o2, o3);
          *(uint2*)(cat + token * 1024 + head * 128 + c) = ov;
        }
    }
  }
}

template <bool SAMPLE>
DEVI void phase_f1(const int TIDX, const Params& p, u16* lds) {
  const int SB = TIDX >> 8, TID = TIDX & 255;
  lds += SB * 32768;
  const u16* H = (const u16*)(p.ws + WS_H);
  const u16* T1 = (const u16*)(p.ws + WS_T1);
  u16* Zt = (u16*)(p.ws + WS_BIG);
  const int NT = 16, MT = SAMPLE ? 128 : 64, ntiles = MT * NT;
  const int lane = TID & 63, wave = TID >> 6, wm = wave >> 1, wn = wave & 1;
  for (int t = 2 * blockIdx.x + SB; t < ntiles; t += 2 * gridDim.x) {
    int mt, nt;
    tile_map(t, NT, mt, nt);
    const int g = nt >> 2, nq = nt & 3;
    f32x16 acc[4][2];
    if (SAMPLE) {
      const long tb = TP + (long)(mt >> 3) * 2048 + 2 * (mt & 7);
      gemm_mainloop(TID, H, [=](int r) { return (tb + (long)(r & 127) * 16 + (r >> 7)) * 1024 + g * 256; },
                    T1 + (size_t)nq * 128 * 256, 256, 256, lds, acc);
    } else {
      const long tb = 2 * mt;
      gemm_mainloop(TID, H, [=](int r) { return (tb + (long)(r & 127) * 128 + (r >> 7)) * 1024 + g * 256; },
                    T1 + (size_t)nq * 128 * 256, 256, 256, lds, acc);
    }
    const int s = nq >> 1;
#pragma unroll
    for (int nb = 0; nb < 2; ++nb) {
      const int cp = g * 256 + (nq & 1) * 128 + wn * 64 + nb * 32 + (lane & 31);
      long rowz;
      if (SAMPLE) rowz = ((long)cp * 16 + (mt >> 3)) * 16 + 2 * (mt & 7) + wm;
      else rowz = (long)cp * 128 + 2 * mt + wm;
      u16* dst = Zt + (rowz * 2 + s) * 128;
#pragma unroll
      for (int mb = 0; mb < 4; ++mb)
#pragma unroll
        for (int rg = 0; rg < 4; ++rg) {
          int n1 = mb * 32 + rg * 8 + (lane >> 5) * 4;
          uint2 ov;
          ov.x = pack2(acc[mb][nb][rg * 4 + 0], acc[mb][nb][rg * 4 + 1]);
          ov.y = pack2(acc[mb][nb][rg * 4 + 2], acc[mb][nb][rg * 4 + 3]);
          *(uint2*)(dst + n1) = ov;
        }
    }
  }
}

template <bool SAMPLE>
DEVI void phase_fa(const int TIDX, const Params& p, u16* lds) {
  const int SB = TIDX >> 8, TID = TIDX & 255;
  lds += SB * 32768;
  const u16* Zt = (const u16*)(p.ws + WS_BIG);
  const u16* T2 = (const u16*)(p.ws + WS_T2);
  u16* Yt = (u16*)(p.ws + WS_BIG) + (SAMPLE ? (size_t)262144 * 256 : (size_t)131072 * 256);
  const int NT = 2, MT = SAMPLE ? 1024 : 512, ntiles = MT * NT;
  const int lane = TID & 63, wave = TID >> 6, wm = wave >> 1, wn = wave & 1;
  for (int t = 2 * blockIdx.x + SB; t < ntiles; t += 2 * gridDim.x) {
    int mt, nt;
    tile_map(t, NT, mt, nt);
    f32x16 acc[4][2];
    const long arow0 = (long)mt * 256;
    gemm_mainloop(TID, Zt, [=](int r) { return (arow0 + r) * 256; }, T2 + (size_t)nt * 128 * 256, 256, 256, lds, acc);
    const int k1 = 32 * (nt * 2 + wn) + (lane & 31);
#pragma unroll
    for (int mb = 0; mb < 4; ++mb)
#pragma unroll
      for (int rg = 0; rg < 4; ++rg) {
        const long row = arow0 + wm * 128 + mb * 32 + rg * 8 + (lane >> 5) * 4;
        float yr[4], yi[4];
        int n2;
        u16 *dre, *dim_;
        if (SAMPLE) {
          n2 = (int)(row & 15);
          int b = (int)((row >> 4) & 15);
          int cp = (int)(row >> 8);
          u16* base = Yt + ((((long)b * 128 + k1) * 1024 + cp) * 2) * 16 + n2;
          dre = base;
          dim_ = base + 16;
        } else {
          n2 = (int)(row & 127);
          int cp = (int)(row >> 7);
          u16* base = Yt + (((long)k1 * 1024 + cp) * 2) * 128 + n2;
          dre = base;
          dim_ = base + 128;
        }
#pragma unroll
        for (int i = 0; i < 4; ++i) {
          float re = acc[mb][0][rg * 4 + i], im = acc[mb][1][rg * 4 + i];
          float ang = (float)((n2 + i) * k1) * (SAMPLE ? (6.283185307179586f / 2048.f) : (6.283185307179586f / 16384.f));
          float ct = __cosf(ang), st = __sinf(ang);
          yr[i] = re * ct + im * st;
          yi[i] = im * ct - re * st;
        }
        uint2 o;
        o.x = pack2(yr[0], yr[1]);
        o.y = pack2(yr[2], yr[3]);
        *(uint2*)dre = o;
        o.x = pack2(yi[0], yi[1]);
        o.y = pack2(yi[2], yi[3]);
        *(uint2*)dim_ = o;
      }
  }
}

DEVI void phase_fb_prompt(const int TIDX, const Params& p, u16* lds) {
  const int SB = TIDX >> 8, TID = TIDX & 255;
  lds += SB * 32768;
  const u16* Yt = (const u16*)p.out;
  const u16* T3 = (const u16*)(p.ws + WS_T3);
  u16* f = (u16*)(p.ws + WS_H);
  const int ntiles = 512;
  const int lane = TID & 63, wave = TID >> 6, wm = wave >> 1, wn = wave & 1;
  for (int t = 2 * blockIdx.x + SB; t < ntiles; t += 2 * gridDim.x) {
    int mt, nt;
    tile_map(t, 1, mt, nt);
    f32x16 acc[4][2];
    const long arow0 = (long)mt * 256;
    gemm_mainloop(TID, Yt, [=](int r) { return (arow0 + r) * 256; }, T3, 256, 256, lds, acc);
#pragma unroll
    for (int nb = 0; nb < 2; ++nb) {
      const int k2 = wn * 64 + nb * 32 + (lane & 31);
#pragma unroll
      for (int mb = 0; mb < 4; ++mb)
#pragma unroll
        for (int rg = 0; rg < 4; ++rg) {
          long row = arow0 + wm * 128 + mb * 32 + rg * 8 + (lane >> 5) * 4;
          int k1 = (int)(row >> 10), cp = (int)(row & 1023);
          long token = k1 + 128 * k2;
          uint2 o;
          o.x = pack2(acc[mb][nb][rg * 4 + 0], acc[mb][nb][rg * 4 + 1]);
          o.y = pack2(acc[mb][nb][rg * 4 + 2], acc[mb][nb][rg * 4 + 3]);
          *(uint2*)(f + token * 1024 + cp) = o;
        }
    }
  }
}

DEVI void phase_fb_sample(const int TIDX, const Params& p) {
  const u16* Yt = (const u16*)p.out + (size_t)131072 * 256;
  u16* f = (u16*)(p.ws + WS_H);
  const int lane = TIDX & 63, wave = TIDX >> 6;
  const int col = lane & 15, kg = lane >> 4;
  bf16x8 bfrag;
#pragma unroll
  for (int j = 0; j < 8; ++j) {
    int k = kg * 8 + j, s = k >> 4, n2 = k & 15;
    int ph = (col * n2) & 15;
    float v = (s == 0 ? cospif((float)ph * 0.125f) : sinpif((float)ph * 0.125f)) * 0.25f;
    bfrag[j] = (short)f2bf(v);
  }
  const int G = 131072;
  const int nw = gridDim.x * 8;
  for (int g0 = blockIdx.x * 8 + wave; g0 < G; g0 += 4 * nw) {
    bf16x8 afrag[4];
#pragma unroll
    for (int i = 0; i < 4; ++i) {
      const long row0 = (long)(g0 + i * nw) * 16;
      afrag[i] = *(const bf16x8*)(Yt + (row0 + (lane & 15)) * 32 + kg * 8);
    }
#pragma unroll
    for (int i = 0; i < 4; ++i) {
      f32x4 acc = {0.f, 0.f, 0.f, 0.f};
      acc = __builtin_amdgcn_mfma_f32_16x16x32_bf16(afrag[i], bfrag, acc, 0, 0, 0);
      const long row = (long)(g0 + i * nw) * 16 + 4 * kg;
      const int cp = (int)(row & 1023), k1 = (int)((row >> 10) & 127), b = (int)(row >> 17);
      const long token = TP + (long)b * 2048 + k1 + 128 * col;
      uint2 o;
      o.x = pack2(acc[0], acc[1]);
      o.y = pack2(acc[2], acc[3]);
      *(uint2*)(f + token * 1024 + cp) = o;
    }
  }
}

DEVI void phase_norm(const int TIDX, const Params& p, int mode, const u16* y, float scale, const float* post_g) {
  u16* xb = (u16*)(p.ws + WS_XB);
  float* stat = (float*)(p.ws + WS_STAT);
  const int lane = TIDX & 63, wave = TIDX >> 6;
  const int stride = gridDim.x * 8;
  int row = blockIdx.x * 8 + wave;
  if (mode == 0) {
    for (; row < T; row += stride) {
      const float* xsrc = row < TP ? p.xp + (long)row * 1024 : p.xs + (long)(row - TP) * 1024;
      float ss = 0.f;
#pragma unroll
      for (int j = 0; j < 2; ++j) {
        const float4 a = ntload_f4(xsrc + j * 512 + lane * 8), b = ntload_f4(xsrc + j * 512 + lane * 8 + 4);
        ss += a.x * a.x + a.y * a.y + a.z * a.z + a.w * a.w + b.x * b.x + b.y * b.y + b.z * b.z + b.w * b.w;
        uint4 o;
        o.x = pack2(a.x, a.y); o.y = pack2(a.z, a.w); o.z = pack2(b.x, b.y); o.w = pack2(b.z, b.w);
        *(uint4*)(xb + (long)row * 1024 + j * 512 + lane * 8) = o;
      }
      ss = wave_sum(ss, lane);
      if (lane == 0) stat[row] = ss;
    }
    return;
  }
  float gp[2][8];
#pragma unroll
  for (int j = 0; j < 2; ++j) {
    const float4 g0 = *(const float4*)(post_g + j * 512 + lane * 8), g1 = *(const float4*)(post_g + j * 512 + lane * 8 + 4);
    gp[j][0] = g0.x * scale; gp[j][1] = g0.y * scale; gp[j][2] = g0.z * scale; gp[j][3] = g0.w * scale;
    gp[j][4] = g1.x * scale; gp[j][5] = g1.y * scale; gp[j][6] = g1.z * scale; gp[j][7] = g1.w * scale;
  }
  uint4 yv[2], xr[2];
  if (row < T) {
#pragma unroll
    for (int j = 0; j < 2; ++j) {
      yv[j] = ntload_u4(y + (long)row * 1024 + j * 512 + lane * 8);
      xr[j] = *(const uint4*)(xb + (long)row * 1024 + j * 512 + lane * 8);
    }
  }
  while (row < T) {
    const int nrow = row + stride;
    uint4 yn[2], xn[2];
    if (nrow < T) {
#pragma unroll
      for (int j = 0; j < 2; ++j) {
        yn[j] = ntload_u4(y + (long)nrow * 1024 + j * 512 + lane * 8);
        xn[j] = *(const uint4*)(xb + (long)nrow * 1024 + j * 512 + lane * 8);
      }
    } else {
#pragma unroll
      for (int j = 0; j < 2; ++j) { yn[j] = yv[j]; xn[j] = xr[j]; }
    }
    float xv[2][8], yf[2][8];
    float ss = 0.f;
#pragma unroll
    for (int j = 0; j < 2; ++j) {
      yf[j][0] = bf_lo(yv[j].x); yf[j][1] = bf_hi(yv[j].x); yf[j][2] = bf_lo(yv[j].y); yf[j][3] = bf_hi(yv[j].y);
      yf[j][4] = bf_lo(yv[j].z); yf[j][5] = bf_hi(yv[j].z); yf[j][6] = bf_lo(yv[j].w); yf[j][7] = bf_hi(yv[j].w);
      xv[j][0] = bf_lo(xr[j].x); xv[j][1] = bf_hi(xr[j].x); xv[j][2] = bf_lo(xr[j].y); xv[j][3] = bf_hi(xr[j].y);
      xv[j][4] = bf_lo(xr[j].z); xv[j][5] = bf_hi(xr[j].z); xv[j][6] = bf_lo(xr[j].w); xv[j][7] = bf_hi(xr[j].w);
#pragma unroll
      for (int e = 0; e < 8; ++e) ss += yf[j][e] * yf[j][e];
    }
    ss = wave_sum(ss, lane);
    const float r = rsqrtf(ss * (1.f / 1024.f) + EPS);
    float sx = 0.f;
#pragma unroll
    for (int j = 0; j < 2; ++j)
#pragma unroll
      for (int e = 0; e < 8; ++e) {
        xv[j][e] += yf[j][e] * r * gp[j][e];
        sx += xv[j][e] * xv[j][e];
      }
    if (mode == 2) {
#pragma unroll
      for (int j = 0; j < 2; ++j) {
        float4 a, b;
        a.x = xv[j][0]; a.y = xv[j][1]; a.z = xv[j][2]; a.w = xv[j][3]; b.x = xv[j][4]; b.y = xv[j][5]; b.z = xv[j][6]; b.w = xv[j][7];
        ntstore_f4(p.out + (long)row * 1024 + j * 512 + lane * 8, a);
        ntstore_f4(p.out + (long)row * 1024 + j * 512 + lane * 8 + 4, b);
      }
    } else {
#pragma unroll
      for (int j = 0; j < 2; ++j) {
        uint4 o;
        o.x = pack2(xv[j][0], xv[j][1]); o.y = pack2(xv[j][2], xv[j][3]); o.z = pack2(xv[j][4], xv[j][5]); o.w = pack2(xv[j][6], xv[j][7]);
        *(uint4*)(xb + (long)row * 1024 + j * 512 + lane * 8) = o;
      }
      sx = wave_sum(sx, lane);
      if (lane == 0) stat[row] = sx;
      if (mode == 3) {
        const float rx = rsqrtf(sx * (1.f / 1024.f) + EPS);
        u16* hrow = (u16*)(p.ws + WS_H) + (long)row * 1024;
#pragma unroll
        for (int j = 0; j < 2; ++j) {
          uint4 o;
          o.x = pack2(xv[j][0] * rx, xv[j][1] * rx); o.y = pack2(xv[j][2] * rx, xv[j][3] * rx);
          o.z = pack2(xv[j][4] * rx, xv[j][5] * rx); o.w = pack2(xv[j][6] * rx, xv[j][7] * rx);
          *(uint4*)(hrow + j * 512 + lane * 8) = o;
        }
      }
    }
#pragma unroll
    for (int j = 0; j < 2; ++j) { yv[j] = yn[j]; xr[j] = xn[j]; }
    row = nrow;
  }
}

DEVI void tconv_tile(const int TIDX, const float* __restrict__ src, int ldsrc, u16* __restrict__ dst, int lddst, int k0, int n0, int rm,
                     float* tl, const float* __restrict__ kscale) {
  const int tid = TIDX;
  {
    const int nn4 = (tid & 15) * 4, kk = tid >> 4;
#pragma unroll
    for (int i = 0; i < 4; ++i) {
      float4 v = *(const float4*)(src + (long)(k0 + kk + 16 * i) * ldsrc + n0 + nn4);
      const float ks = kscale ? kscale[k0 + kk + 16 * i] : 1.f;
      float* d = tl + (kk + 16 * i) * 65 + nn4;
      d[0] = v.x * ks; d[1] = v.y * ks; d[2] = v.z * ks; d[3] = v.w * ks;
    }
  }
  __syncthreads();
  {
    const int kk8 = (tid & 7) * 8, nn = tid >> 3;
#pragma unroll
    for (int i = 0; i < 2; ++i) {
      int n = nn + 32 * i;
      float v[8];
#pragma unroll
      for (int j = 0; j < 8; ++j) v[j] = tl[(kk8 + j) * 65 + n];
      uint4 o;
      o.x = pack2(v[0], v[1]); o.y = pack2(v[2], v[3]); o.z = pack2(v[4], v[5]); o.w = pack2(v[6], v[7]);
      int ng = n0 + n;
      int drow = (rm == 0) ? ng : (256 * (ng >> 7) + (ng & 127) + (rm == 2 ? 128 : 0));
      *(uint4*)(dst + (long)drow * lddst + k0 + kk8) = o;
    }
  }
  __syncthreads();
}

DEVI void prep_ffn_tile(const int TID, const Params& p, int f, int t, float* tl) {
  const int kind = t / 704, tt = t - kind * 704, j = f & 1;
  if (kind < 2) {
    const float* src = (kind ? p.w_up : p.w_gate) + (size_t)f * 1024 * 2816;
    u16* dst = (u16*)(p.ws + WS_WGU) + (size_t)j * 5632 * 1024;
    tconv_tile(TID, src, 2816, dst, 1024, (tt & 15) * 64, (tt >> 4) * 64, kind ? 2 : 1, tl, p.ffn_pre_g + f * 1024);
  } else {
    const float* src = p.w_down + (size_t)f * 2816 * 1024;
    u16* dst = (u16*)(p.ws + WS_WD) + (size_t)j * 1024 * 2816;
    tconv_tile(TID, src, 1024, dst, 2816, (tt % 44) * 64, (tt / 44) * 64, 0, tl, nullptr);
  }
}
DEVI void prep_ffn_in_tail(const int TIDX, const Params& p, int f, float* tl) {
  if (blockIdx.x < 128 || gridDim.x != 256) return;
  const int SB = TIDX >> 8, TID = TIDX & 255;
  tl += SB * 16384;
  for (int t = 2 * ((int)blockIdx.x - 128) + SB; t < 2112; t += 256) prep_ffn_tile(TID, p, f, t, tl);
}
DEVI void prep_ffn_all(const int TIDX, const Params& p, int f, float* tl) {
  const int SB = TIDX >> 8, TID = TIDX & 255;
  tl += SB * 16384;
  for (int t = 2 * blockIdx.x + SB; t < 2112; t += 2 * gridDim.x) prep_ffn_tile(TID, p, f, t, tl);
}
DEVI void phase_prep(const int TIDX, const Params& p, float* tl) {
  const int SB = TIDX >> 8, TID = TIDX & 255;
  tl += SB * 16384;
  const int ntiles = 2112 + 512 + 512;
  for (int t = 2 * blockIdx.x + SB; t < ntiles; t += 2 * gridDim.x) {
    if (t < 2112) {
      prep_ffn_tile(TID, p, 0, t, tl);
    } else if (t < 2624) {
      int tt = t - 2112;
      tconv_tile(TID, p.ab_w_in, 2048, (u16*)(p.ws + WS_WIN), 1024, (tt & 15) * 64, (tt >> 4) * 64, 0, tl, p.mix_pre_g);
    } else {
      int tt = t - 2624, i = tt >> 8, t2 = tt & 255;
      tconv_tile(TID, p.mix_w_out + (size_t)i * 1024 * 1024, 1024, (u16*)(p.ws + WS_WOUT) + (size_t)i * 1024 * 1024, 1024,
                 (t2 & 15) * 64, (t2 >> 4) * 64, 0, tl, nullptr);
    }
  }
  const int gtid = blockIdx.x * 512 + TIDX, nth = gridDim.x * 512;
  u16* sgw = (u16*)(p.ws + WS_SGW);
  u16* T1 = (u16*)(p.ws + WS_T1);
  u16* T2 = (u16*)(p.ws + WS_T2);
  u16* T3 = (u16*)(p.ws + WS_T3);
  for (int e = gtid; e < 65536 + 524288 + 65536 + 32768; e += nth) {
    if (e < 65536) {
      sgw[e] = f2bf(p.sg_w[e]);
    } else if (e < 65536 + 524288) {
      int i = e - 65536, grp = i >> 17, n = (i >> 8) & 511, k = i & 255;
      int s = n >> 8, m = n & 255;
      int ph = (m * k) & 255;
      float a = (float)ph * (1.f / 128.f);
      float v = (s == 0 ? cospif(a) : -sinpif(a)) * (1.f / 16.f) * p.mix_pre_g[1024 + grp * 256 + k];
      T1[i] = f2bf(v);
    } else if (e < 65536 + 524288 + 65536) {
      int i = e - 65536 - 524288, n = i >> 8, k = i & 255;
      int sp = n >> 7, k1 = n & 127;
      int s = k >> 7, n1 = k & 127;
      int ph = (k1 * n1) & 127;
      float a = (float)ph * (1.f / 64.f);
      float C = cospif(a), S = sinpif(a);
      float v = (sp == 0) ? (s == 0 ? C : S) : (s == 0 ? -S : C);
      T2[i] = f2bf(v * 0.08838834764831845f);
    } else {
      int i = e - 65536 - 524288 - 65536, k2 = i >> 8, k = i & 255;
      int s = k >> 7, n2 = k & 127;
      int ph = (k2 * n2) & 127;
      float a = (float)ph * (1.f / 64.f);
      float v = (s == 0 ? cospif(a) : sinpif(a)) * 0.08838834764831845f;
      T3[i] = f2bf(v);
    }
  }
}

DEVI void phase_lnv(const int TIDX, const Params& p, u16* ldt) {
  const int SB = TIDX >> 8, TID = TIDX & 255;
  ldt += SB * 32768;
  const u16* proj = (const u16*)(p.ws + WS_BIG);
  u16* vt = (u16*)(p.ws + WS_BIG) + (size_t)T * 2048;
  const int lane = TID & 63, wave = TID >> 6, tid = TID;
  constexpr int LR = 132;
  for (int t = 2 * blockIdx.x + SB; t < 1536; t += 2 * gridDim.x) {
    const int chunk = t >> 2, head = t & 3;
    const float g0 = p.sg_ln_g[head * 128 + lane], g1 = p.sg_ln_g[head * 128 + 64 + lane];
    const float b0 = p.sg_ln_b[head * 128 + lane], b1 = p.sg_ln_b[head * 128 + 64 + lane];
#pragma unroll 1
    for (int pb = 0; pb < 4; ++pb) {
      const int pos0 = wave * 32 + pb * 8;
      const u16* src0 = proj + ((long)chunk * 128 + pos0) * 2048 + 512;
      uint4 sv[8];
      u16 h0[8], h1[8];
#pragma unroll
      for (int i = 0; i < 8; ++i) {
        const u16* src = src0 + (long)i * 2048;
        sv[i] = *(const uint4*)(src + lane * 8);
        h0[i] = src[head * 128 + lane];
        h1[i] = src[head * 128 + 64 + lane];
      }
      float sm[8], sq[8];
#pragma unroll
      for (int i = 0; i < 8; ++i) {
        const float e0 = bf_lo(sv[i].x), e1 = bf_hi(sv[i].x), e2 = bf_lo(sv[i].y), e3 = bf_hi(sv[i].y);
        const float e4 = bf_lo(sv[i].z), e5 = bf_hi(sv[i].z), e6 = bf_lo(sv[i].w), e7 = bf_hi(sv[i].w);
        sm[i] = ((e0 + e1) + (e2 + e3)) + ((e4 + e5) + (e6 + e7));
        sq[i] = ((e0 * e0 + e1 * e1) + (e2 * e2 + e3 * e3)) + ((e4 * e4 + e5 * e5) + (e6 * e6 + e7 * e7));
      }
#pragma unroll
      for (int m = 32; m >= 1; m >>= 1) {
#pragma unroll
        for (int i = 0; i < 8; ++i) {
          sm[i] += shx(sm[i], m, lane);
          sq[i] += shx(sq[i], m, lane);
        }
      }
#pragma unroll
      for (int i = 0; i < 8; ++i) {
        const float mean = sm[i] * (1.f / 512.f);
        const float var = fmaxf(sq[i] * (1.f / 512.f) - mean * mean, 0.f);
        const float r = rsqrtf(var + EPS);
        ldt[lane * LR + pos0 + i] = f2bf((bf2f(h0[i]) - mean) * r * g0 + b0);
        ldt[(lane + 64) * LR + pos0 + i] = f2bf((bf2f(h1[i]) - mean) * r * g1 + b1);
      }
    }
    __syncthreads();
#pragma unroll
    for (int it = 0; it < 8; ++it) {
      int item = it * 256 + tid, pg = item & 15, c = item >> 4;
      const uint2* s2 = (const uint2*)(ldt + c * LR + pg * 8);
      uint2 lo = s2[0], hi = s2[1];
      uint4 o;
      o.x = lo.x; o.y = lo.y; o.z = hi.x; o.w = hi.y;
      *(uint4*)(vt + (((long)head * 384 + chunk) * 128 + c) * 128 + pg * 8) = o;
    }
    __syncthreads();
  }
}

template <int RR>
struct ConvRow {
  static DEVI void run(const u32* lc, int tid, const float (&w)[31][2], float (&o)[32][2]) {
    const u32 cv = lc[RR * 256 + tid];
    const float c0 = bf_lo(cv), c1 = bf_hi(cv);
#pragma unroll
    for (int j = 0; j < 31; ++j) {
      const int tt = RR - j;
      if (tt >= 0 && tt < 32) {
        o[tt][0] += w[j][0] * c0;
        o[tt][1] += w[j][1] * c1;
      }
    }
    ConvRow<RR + 1>::run(lc, tid, w, o);
  }
};
template <>
struct ConvRow<62> {
  static DEVI void run(const u32*, int, const float (&)[31][2], float (&)[32][2]) {}
};

DEVI void phase_conv(const int TIDX, const Params& p, unsigned char* ldsb) {
  const int SB = TIDX >> 8, TID = TIDX & 255;
  ldsb += SB * 65536;
  const u16* proj = (const u16*)(p.ws + WS_BIG);
  u16* cat = (u16*)(p.ws + WS_H);
  u32* lc = (u32*)ldsb;
  float* lf = (float*)ldsb;
  const int lane = TID & 63, wave = TID >> 6, tid = TID;
  float w[31][2];
#pragma unroll
  for (int j = 0; j < 31; ++j) {
    float2 wv = *(const float2*)(p.conv_w + j * 512 + 2 * tid);
    w[j][0] = wv.x;
    w[j][1] = wv.y;
  }
  const float2 cb = *(const float2*)(p.conv_b + 2 * tid);
  float lg[8], lb[8];
#pragma unroll
  for (int j = 0; j < 8; ++j) {
    lg[j] = p.conv_ln_g[lane * 8 + j];
    lb[j] = p.conv_ln_b[lane * 8 + j];
  }
  for (int t = 2 * blockIdx.x + SB; t < 1536; t += 2 * gridDim.x) {
    const int t0 = t * 32;
    int seq_lo, seq_hi;
    if (t0 < TP) { seq_lo = 0; seq_hi = TP; }
    else { seq_lo = TP + ((t0 - TP) >> 11) * 2048; seq_hi = seq_lo + 2048; }
#pragma unroll 1
    for (int r0 = 0; r0 < 64; r0 += 32) {
      u32 av[32], gv[32];
#pragma unroll
      for (int i = 0; i < 32; ++i) {
        const int tok = t0 - 15 + r0 + i;
        av[i] = 0; gv[i] = 0;
        if (r0 + i < 62 && tok >= seq_lo && tok < seq_hi) {
          av[i] = *(const u32*)(proj + (long)tok * 2048 + 1024 + 2 * tid);
          gv[i] = *(const u32*)(proj + (long)tok * 2048 + 1536 + 2 * tid);
        }
      }
#pragma unroll
      for (int i = 0; i < 32; ++i) {
        if (r0 + i < 62)
          lc[(r0 + i) * 256 + tid] = pack2(bf_lo(av[i]) * sigmoidf_(bf_lo(gv[i])), bf_hi(av[i]) * sigmoidf_(bf_hi(gv[i])));
      }
    }
    float o[32][2];
#pragma unroll
    for (int i = 0; i < 32; ++i) { o[i][0] = cb.x; o[i][1] = cb.y; }
    ConvRow<0>::run(lc, tid, w, o);
    __syncthreads();
#pragma unroll
    for (int i = 0; i < 32; ++i) {
      float2 ov; ov.x = o[i][0]; ov.y = o[i][1];
      *(float2*)(lf + i * 512 + 2 * tid) = ov;
    }
    __syncthreads();
#pragma unroll 1
    for (int ib = 0; ib < 2; ++ib) {
      float v[4][8], sm[4], sq[4];
#pragma unroll
      for (int i = 0; i < 4; ++i) {
        const int tl = wave * 8 + ib * 4 + i;
        const float4 v0 = *(const float4*)(lf + tl * 512 + lane * 8);
        const float4 v1 = *(const float4*)(lf + tl * 512 + lane * 8 + 4);
        v[i][0] = v0.x; v[i][1] = v0.y; v[i][2] = v0.z; v[i][3] = v0.w; v[i][4] = v1.x; v[i][5] = v1.y; v[i][6] = v1.z; v[i][7] = v1.w;
        sm[i] = ((v0.x + v0.y) + (v0.z + v0.w)) + ((v1.x + v1.y) + (v1.z + v1.w));
      }
#pragma unroll
      for (int m = 32; m >= 1; m >>= 1)
#pragma unroll
        for (int i = 0; i < 4; ++i) sm[i] += shx(sm[i], m, lane);
#pragma unroll
      for (int i = 0; i < 4; ++i) {
        const float mean = sm[i] * (1.f / 512.f);
        sq[i] = 0.f;
#pragma unroll
        for (int j = 0; j < 8; ++j) { v[i][j] -= mean; sq[i] += v[i][j] * v[i][j]; }
      }
#pragma unroll
      for (int m = 32; m >= 1; m >>= 1)
#pragma unroll
        for (int i = 0; i < 4; ++i) sq[i] += shx(sq[i], m, lane);
#pragma unroll
      for (int i = 0; i < 4; ++i) {
        const int tl = wave * 8 + ib * 4 + i;
        const float r = rsqrtf(sq[i] * (1.f / 512.f) + EPS);
#pragma unroll
        for (int j = 0; j < 8; ++j) v[i][j] = siluf_(v[i][j] * r * lg[j] + lb[j]);
        uint4 ov;
        ov.x = pack2(v[i][0], v[i][1]); ov.y = pack2(v[i][2], v[i][3]); ov.z = pack2(v[i][4], v[i][5]); ov.w = pack2(v[i][6], v[i][7]);
        *(uint4*)(cat + (long)(t0 + tl) * 1024 + 512 + lane * 8) = ov;
      }
    }
    __syncthreads();
  }
}

__global__ void __launch_bounds__(512, 2) fwd_megakernel(Params p) {
  cg::grid_group grid = cg::this_grid();
  extern __shared__ __attribute__((aligned(16))) unsigned char lds_raw[];
  u16* lds = (u16*)lds_raw;
  LAS unsigned char* ldsl = (LAS unsigned char*)lds_raw;
  __shared__ uint4 xb_words;
  if (threadIdx.x == 0) xb_words = make_uint4(0u, 0u, 0u, 0u);
  __syncthreads();
  const int wave_s = __builtin_amdgcn_readfirstlane((int)(threadIdx.x >> 6));
  XcdBarrier xb = xcd_barrier_post((int)threadIdx.x, (unsigned*)(p.ws + WS_BAR), (volatile LAS3 unsigned*)&xb_words);
#ifndef PROBE_DUP
#define PROBE_DUP 0
#endif
#if PROBE_DUP
  static constexpr unsigned char prog[] = {0, 1, 1, 2, 2, 3, 4, 4, 5, 6, 7, 7, 19, 17, 17, 18, 18, 35, 33, 33, 34, 34, 51, 8, 9, 10, 11, 12, 13, 23, 23, 67, 49, 49, 50, 50, 83};
#else
  static constexpr unsigned char prog[] = {0, 1, 2, 3, 4, 5, 6, 7, 19, 17, 18, 35, 33, 34, 51, 8, 9, 10, 23, 67, 49, 50, 83};
#endif
  constexpr int NPH = (int)sizeof(prog);
#pragma unroll 1
  for (int ph = 0; ph < NPH; ++ph) {
    const int op = prog[ph] & 15, arg = prog[ph] >> 4;
    const int reps = (op == 1 || op == 2 || op == 4 || op == 7) ? REP_BIG : ((op == 5 || op == 6 || op >= 8) ? REP_SMALL : 1);
    for (int rep = 0; rep < reps; ++rep) {
      if (rep) { int t2 = threadIdx.x; asm volatile("" : "+v"(t2)); xcd_barrier(t2, xb); }
      int tid = threadIdx.x;
      asm volatile("" : "+v"(tid));
    switch (op) {
        case 0:
          phase_prep(tid, p, (float*)lds_raw);
          phase_norm(tid, p, 0, nullptr, 0.f, nullptr);
          break;
        case 1:
          phase_g1(tid, p, arg, ldsl);
          if (arg < 3) {
            if (gridDim.x == 256) prep_ffn_in_tail(tid, p, arg + 1, (float*)lds_raw);
            else prep_ffn_all(tid, p, arg + 1, (float*)lds_raw);
          }
          break;
        case 2: phase_g2(tid, p, arg, ldsl); break;
        case 3: {
          const bool mix = (arg == 1 || arg == 4);
          const int fidx = (arg == 0) ? 0 : (arg == 2) ? 1 : (arg == 3) ? 2 : 3;
          const float* post = mix ? p.mix_post_g + (arg == 1 ? 0 : 1024) : p.ffn_post_g + fidx * 1024;
          phase_norm(tid, p, arg == 5 ? 2 : (arg == 3 ? 3 : 1), (const u16*)(p.ws + (mix ? WS_BIG : WS_H)), mix ? 1.0f : 0.5f, post);
        } break;
        case 4: phase_gin(tid, p, ldsl); break;
        case 5:
          phase_lnv(tid, p, lds);
          phase_conv(tid, p, lds_raw);
          break;
        case 6: phase_sgu(tid, p, lds); break;
        case 7: phase_gout(tid, p, arg, ldsl); break;
        case 8: {
          unsigned am0 = ~0u; asm volatile("" : "+s"(am0)); int t2 = wave_s * 64 + (int)__builtin_amdgcn_mbcnt_hi(am0, __builtin_amdgcn_mbcnt_lo(am0, 0u)); asm volatile("" : "+v"(t2));
          phase_f1_pg8<false>(t2, p, ldsl);
          unsigned am = ~0u; asm volatile("" : "+s"(am)); int t3 = wave_s * 64 + (int)__builtin_amdgcn_mbcnt_hi(am, __builtin_amdgcn_mbcnt_lo(am, 0u)); asm volatile("" : "+v"(t3));
          phase_f1_pg8<true>(t3, p, ldsl);
        } break;
        case 9: {
          unsigned am0 = ~0u; asm volatile("" : "+s"(am0)); int t2 = wave_s * 64 + (int)__builtin_amdgcn_mbcnt_hi(am0, __builtin_amdgcn_mbcnt_lo(am0, 0u)); asm volatile("" : "+v"(t2));
          phase_fa_pg8<false>(t2, p, ldsl);
          unsigned am = ~0u; asm volatile("" : "+s"(am)); int t3 = wave_s * 64 + (int)__builtin_amdgcn_mbcnt_hi(am, __builtin_amdgcn_mbcnt_lo(am, 0u)); asm volatile("" : "+v"(t3));
          phase_fa_pg8<true>(t3, p, ldsl);
        } break;
        default: {
          unsigned am0 = ~0u; asm volatile("" : "+s"(am0)); int t2 = wave_s * 64 + (int)__builtin_amdgcn_mbcnt_hi(am0, __builtin_amdgcn_mbcnt_lo(am0, 0u)); asm volatile("" : "+v"(t2));
          phase_fb_prompt(t2, p, lds);
          unsigned am = ~0u; asm volatile("" : "+s"(am)); int t3 = wave_s * 64 + (int)__builtin_amdgcn_mbcnt_hi(am, __builtin_amdgcn_mbcnt_lo(am, 0u)); asm volatile("" : "+v"(t3));
          phase_fb_sample(t3, p);
        } break;
      }
    }
    if (ph != NPH - 1) for (int rb = 0; rb < REP_BAR; ++rb) {
      if (p.ws == nullptr) grid_barrier(grid);
      { int t2 = threadIdx.x; asm volatile("" : "+v"(t2)); xcd_barrier(t2, xb); }
    }
  }
}

extern "C" void kernel_launch(void* const* d_in, const int* in_sizes, int n_in, void* d_out, int out_size, void* d_ws,
                              size_t ws_size, hipStream_t stream) {
  static int grid_blocks = 0;
  if (!grid_blocks) {
    int dev = 0, cus = 0, per_cu = 0;
    (void)hipGetDevice(&dev);
    (void)hipDeviceGetAttribute(&cus, hipDeviceAttributeMultiprocessorCount, dev);
    (void)hipFuncSetAttribute((const void*)fwd_megakernel, hipFuncAttributeMaxDynamicSharedMemorySize, 131072);
    (void)hipOccupancyMaxActiveBlocksPerMultiprocessor(&per_cu, fwd_megakernel, 512, 131072);
    if (per_cu > 1) per_cu = 1;
    if (per_cu < 1) per_cu = 1;
    grid_blocks = cus * per_cu;
    if (ws_size < WS_END) {
      fprintf(stderr, "workspace too small: %zu < %zu\n", ws_size, (size_t)WS_END);
      grid_blocks = -1;
    }
  }
  if (grid_blocks < 0) return;
  Params p{};
  p.xp = (const float*)d_in[0]; p.xs = (const float*)d_in[1]; p.ffn_pre_g = (const float*)d_in[2];
  p.w_gate = (const float*)d_in[3]; p.w_up = (const float*)d_in[4]; p.w_down = (const float*)d_in[5];
  p.ffn_post_g = (const float*)d_in[6]; p.mix_pre_g = (const float*)d_in[7]; p.mix_w_out = (const float*)d_in[8];
  p.mix_post_g = (const float*)d_in[9]; p.ab_w_in = (const float*)d_in[10]; p.sg_ln_g = (const float*)d_in[11];
  p.sg_ln_b = (const float*)d_in[12]; p.sg_w = (const float*)d_in[13]; p.sg_b = (const float*)d_in[14];
  p.conv_w = (const float*)d_in[15]; p.conv_b = (const float*)d_in[16]; p.conv_ln_g = (const float*)d_in[17];
  p.conv_ln_b = (const float*)d_in[18];
  p.out = (float*)d_out;
  p.ws = (unsigned char*)d_ws;
  (void)hipMemsetAsync((unsigned char*)d_ws + WS_BAR, 0, 16384, stream);
  void* args[] = {&p};
  hipError_t e = hipLaunchCooperativeKernel((void*)fwd_megakernel, dim3(grid_blocks), dim3(512), args, 131072, stream);
  if (e != hipSuccess) fprintf(stderr, "cooperative launch failed: %s (grid %d)\n", hipGetErrorString(e), grid_blocks);
}
```
